# Optimizing an MI355X kernel written in HIP

```python
import jax, jax.numpy as jnp
from jax import lax
import numpy as np

D_MODEL = 1024
BATCH = 8
SEQ = 4096
DEPTH = 2

CHUNK = 64
Q_BLOCK = 128
HEAD_DIM = 64
SB_HEADS = D_MODEL // 256
SB_WIDTH = SB_HEADS * HEAD_DIM
RET_HEADS = D_MODEL // 128
RET_WIDTH = RET_HEADS * HEAD_DIM
CONV_WIDTH = D_MODEL - SB_WIDTH - RET_WIDTH
CONV_KERNEL = 31
D_FF = 4 * D_MODEL
EPS = 1e-6
ROPE_BASE = 10000.0
IN_COLS = 3 * SB_WIDTH + 4 * RET_WIDTH + 2 * CONV_WIDTH

kernel_name = "hybrid_sb_retention_conformer_block"


def rms_norm(x, g):
    x32 = x.astype(jnp.float32)
    y = x32 * lax.rsqrt(jnp.mean(x32 * x32, axis=-1, keepdims=True) + EPS)
    return (y * g.astype(jnp.float32)).astype(x.dtype)


def layer_norm(x, g, b):
    x32 = x.astype(jnp.float32)
    mu = jnp.mean(x32, axis=-1, keepdims=True)
    xc = x32 - mu
    y = xc * lax.rsqrt(jnp.mean(xc * xc, axis=-1, keepdims=True) + EPS)
    return y * g.astype(jnp.float32) + b.astype(jnp.float32)


def to_heads(t, n_heads):
    B, T, _ = t.shape
    return t.reshape(B, T, n_heads, HEAD_DIM).transpose(0, 2, 1, 3)


def from_heads(t):
    B, H, T, d = t.shape
    return t.transpose(0, 2, 1, 3).reshape(B, T, H * d)


def stick_breaking_attention(q, k, v):
    B, H, T, d = q.shape
    nb = T // Q_BLOCK
    q_blocks = jnp.moveaxis(q.reshape(B, H, nb, Q_BLOCK, d), 2, 0)
    key_pos = jnp.arange(T)
    scale = d ** -0.5

    def one_block(args):
        q_blk, b_idx = args
        z = jnp.einsum('bhqd,bhkd->bhqk', q_blk, k) * scale
        q_pos = b_idx * Q_BLOCK + jnp.arange(Q_BLOCK)
        mask = key_pos[None, :] < q_pos[:, None]
        log_beta = jax.nn.log_sigmoid(z)
        log_keep = jnp.where(mask, jax.nn.log_sigmoid(-z), 0.0)
        shifted = jnp.concatenate([log_keep[..., 1:], jnp.zeros_like(log_keep[..., :1])], axis=-1)
        tail = lax.cumsum(shifted, axis=3, reverse=True)
        w = jnp.where(mask, jnp.exp(log_beta + tail), 0.0)
        return jnp.einsum('bhqk,bhkd->bhqd', w, v)

    out = lax.map(one_block, (q_blocks, jnp.arange(nb)))
    return jnp.moveaxis(out, 0, 2).reshape(B, H, T, d)


def retention_rotary(x, pos):
    d = x.shape[-1]
    inv = 1.0 / (ROPE_BASE ** jnp.linspace(0.0, 1.0, d // 2, dtype=jnp.float32))
    ang = pos.astype(jnp.float32)[:, None] * inv[None, :]
    cos, sin = jnp.cos(ang), jnp.sin(ang)
    x1, x2 = x[..., 0::2], x[..., 1::2]
    return jnp.stack([x1 * cos - x2 * sin, x1 * sin + x2 * cos], axis=-1).reshape(x.shape)


def multiscale_retention(q, k, v):
    B, H, T, d = q.shape
    C = CHUNK
    nc = T // C
    log_g = jnp.log(1.0 - jnp.exp2(-5.0 - jnp.arange(H, dtype=jnp.float32)))
    j = jnp.arange(C, dtype=jnp.float32)
    rel = j[:, None] - j[None, :]
    intra_decay = jnp.where(rel >= 0, jnp.exp(log_g[:, None, None] * jnp.maximum(rel, 0.0)), 0.0)

    qc = q.reshape(B, H, nc, C, d)
    kc = k.reshape(B, H, nc, C, d)
    vc = v.reshape(B, H, nc, C, d)

    scores = jnp.einsum('bhncd,bhnsd->bhncs', qc, kc) * intra_decay[None, :, None]
    out_intra = jnp.einsum('bhncs,bhnsd->bhncd', scores, vc)

    k_dec = kc * jnp.exp(log_g[:, None] * (C - 1.0 - j)[None, :])[None, :, None, :, None]
    chunk_kv = jnp.einsum('bhncd,bhnce->bhnde', k_dec, vc)
    chunk_decay = jnp.exp(log_g * C)[None, :, None, None]

    def step(state, kv):
        return state * chunk_decay + kv, state

    _, prev_states = lax.scan(step, jnp.zeros((B, H, d, d), jnp.float32), jnp.moveaxis(chunk_kv, 2, 0))
    prev_states = jnp.moveaxis(prev_states, 0, 2)

    q_dec = qc * jnp.exp(log_g[:, None] * (j + 1.0)[None, :])[None, :, None, :, None]
    out_inter = jnp.einsum('bhncd,bhnde->bhnce', q_dec, prev_states)
    return (out_intra + out_inter).reshape(B, H, T, d)


def conformer_conv(a, gate, pw_b, dw_w, dw_b, ln_g, ln_b):
    c = a.shape[-1]
    pw_b = pw_b.astype(jnp.float32)
    h = (a.astype(jnp.float32) + pw_b[:c]) * jax.nn.sigmoid(gate.astype(jnp.float32) + pw_b[c:])
    h = lax.conv_general_dilated(
        h, dw_w.astype(jnp.float32)[:, None, :], window_strides=(1,),
        padding=[(CONV_KERNEL - 1, 0)], dimension_numbers=('NWC', 'WIO', 'NWC'),
        feature_group_count=c) + dw_b.astype(jnp.float32)
    return jax.nn.silu(layer_norm(h, ln_g, ln_b))


def setup_inputs(seed: int = 0) -> dict:
    key = jax.random.key(seed)
    ks = jax.random.split(key, 16)
    f32 = jnp.float32
    nrm = lambda k, shape, s: jax.random.normal(k, shape, f32) * s
    return {
        "x": nrm(ks[0], (BATCH, SEQ, D_MODEL), 1.0),
        "mix_norm_g": 1.0 + nrm(ks[1], (DEPTH, D_MODEL), 0.02),
        "w_in": nrm(ks[2], (DEPTH, D_MODEL, IN_COLS), D_MODEL ** -0.5),
        "sb_q_norm_g": 1.0 + nrm(ks[3], (DEPTH, HEAD_DIM), 0.02),
        "sb_k_norm_g": 1.0 + nrm(ks[4], (DEPTH, HEAD_DIM), 0.02),
        "ret_norm_g": 1.0 + nrm(ks[5], (DEPTH, RET_WIDTH), 0.02),
        "conv_pw_b": nrm(ks[6], (DEPTH, 2 * CONV_WIDTH), 0.02),
        "conv_dw_w": nrm(ks[7], (DEPTH, CONV_KERNEL, CONV_WIDTH), CONV_KERNEL ** -0.5),
        "conv_dw_b": nrm(ks[8], (DEPTH, CONV_WIDTH), 0.02),
        "conv_ln_g": 1.0 + nrm(ks[9], (DEPTH, CONV_WIDTH), 0.02),
        "conv_ln_b": nrm(ks[10], (DEPTH, CONV_WIDTH), 0.02),
        "w_out": nrm(ks[11], (DEPTH, D_MODEL, D_MODEL), D_MODEL ** -0.5),
        "mlp_norm_g": 1.0 + nrm(ks[12], (DEPTH, D_MODEL), 0.02),
        "w_ff1": nrm(ks[13], (DEPTH, D_MODEL, D_FF), D_MODEL ** -0.5),
        "w_ff2": nrm(ks[14], (DEPTH, D_FF, D_MODEL), D_FF ** -0.5),
    }


def reference(x, mix_norm_g, w_in, sb_q_norm_g, sb_k_norm_g, ret_norm_g, conv_pw_b,
              conv_dw_w, conv_dw_b, conv_ln_g, conv_ln_b, w_out, mlp_norm_g, w_ff1, w_ff2):
    B, T, _ = x.shape
    pos = jnp.arange(T)
    split_at = np.cumsum([SB_WIDTH] * 3 + [RET_WIDTH] * 4 + [CONV_WIDTH])
    for l in range(DEPTH):
        h = rms_norm(x, mix_norm_g[l])
        u = jnp.einsum('btd,dc->btc', h, w_in[l])
        sb_q, sb_k, sb_v, r_q, r_k, r_v, r_g, c_a, c_gate = jnp.split(u, split_at, axis=-1)

        q = to_heads(rms_norm(sb_q.reshape(B, T, SB_HEADS, HEAD_DIM), sb_q_norm_g[l]).reshape(B, T, SB_WIDTH), SB_HEADS)
        k = to_heads(rms_norm(sb_k.reshape(B, T, SB_HEADS, HEAD_DIM), sb_k_norm_g[l]).reshape(B, T, SB_WIDTH), SB_HEADS)
        v = to_heads(sb_v, SB_HEADS)
        y_sb = from_heads(stick_breaking_attention(q.astype(jnp.float32), k.astype(jnp.float32),
                                                   v.astype(jnp.float32)))

        rq = retention_rotary(to_heads(r_q, RET_HEADS).astype(jnp.float32), pos)
        rk = retention_rotary(to_heads(r_k, RET_HEADS).astype(jnp.float32), pos) * (HEAD_DIM ** -0.5)
        rv = to_heads(r_v, RET_HEADS).astype(jnp.float32)
        ret = from_heads(multiscale_retention(rq, rk, rv)).reshape(B, T, RET_HEADS, HEAD_DIM)
        ret = rms_norm(ret, ret_norm_g[l].reshape(RET_HEADS, HEAD_DIM)).reshape(B, T, RET_WIDTH)
        y_ret = jax.nn.silu(r_g.astype(jnp.float32)) * ret

        y_conv = conformer_conv(c_a, c_gate, conv_pw_b[l], conv_dw_w[l], conv_dw_b[l],
                                conv_ln_g[l], conv_ln_b[l])

        mixed = jnp.concatenate([y_sb, y_ret, y_conv], axis=-1).astype(x.dtype)
        x = x + jnp.einsum('btc,cd->btd', mixed, w_out[l])

        h = rms_norm(x, mlp_norm_g[l])
        f = jnp.square(jax.nn.relu(jnp.einsum('btd,df->btf', h, w_ff1[l])))
        x = x + jnp.einsum('btf,fd->btd', f, w_ff2[l])
    return x
```

```cpp
#include <hip/hip_runtime.h>
#include <hip/hip_cooperative_groups.h>
#include <cstdio>
#include <cstdint>
#include <cmath>
namespace cg = cooperative_groups;

#ifndef MK_ONE_LAUNCH
#define MK_ONE_LAUNCH 0
#endif
namespace pg8 {
#define PG8_LAS __attribute__((address_space(3)))
typedef unsigned short bf16_t;
typedef short bf16x8 __attribute__((ext_vector_type(8)));
typedef float f32x4 __attribute__((ext_vector_type(4)));
typedef unsigned u32x4 __attribute__((ext_vector_type(4)));
constexpr int BM = 256, BK = 64, HALF = 128, HTB = HALF * BK * 2  , STAGE_BYTES = 8 * HTB, NXCD = 8, WGM = 8;

__host__ __device__ __forceinline__ int lds_byte(int r, int c) { const int st = (r >> 4) * 2 + (c >> 5), rr = r & 15, cc = c & 31, ob = rr * 64 + cc * 2; return st * 1024 + (ob ^ (((ob >> 9) & 1) << 5)); }
__host__ __device__ __forceinline__ void stage_rc(int b, int& R, int& C) { const int st = b / 1024, sb = b % 1024, swz = sb ^ (((sb >> 9) & 1) << 5); R = (st >> 1) * 16 + swz / 64; C = (st & 1) * 32 + (swz % 64) / 2; }
__host__ __device__ __forceinline__ int perm32(int rho) { const int n = rho >> 4, i = rho & 15; return 8 * (i >> 2) + 4 * n + (i & 3); }

struct Unit { int pm, pn; };
struct Gemm { const bf16_t* A; const bf16_t* Bt; int M, N, K; };

struct StaticOrder {
    int nM, nN, nwg, G, c;
    __host__ __device__ void init(int M, int N, int G_, int c_) { nM = M / BM; nN = N / BM; nwg = nM * nN; G = G_; c = c_; }
    __host__ __device__ bool next(int i, Unit& u) const {
        const long L = (long)i * G + c; if (L >= nwg) return false;
        int wgid = (int)L; { const int q = nwg / NXCD, r = nwg % NXCD, xcd = wgid % NXCD, off = wgid / NXCD; wgid = (xcd < r ? xcd * (q + 1) : r * (q + 1) + (xcd - r) * q) + off; }
        const int nig = WGM * nN, gid = wgid / nig, fm = gid * WGM, gsz = (nM - fm) < WGM ? (nM - fm) : WGM;
        u.pm = fm + ((wgid % nig) % gsz); u.pn = (wgid % nig) / gsz; return true;
    }
    __device__ __forceinline__ void a_ready(const Unit&) const {}
    __device__ __forceinline__ void done(const Unit&) const {}
};

__device__ __forceinline__ unsigned cvt_pk_bf16(float lo, float hi) { unsigned r; asm volatile("v_cvt_pk_bf16_f32 %0, %1, %2" : "=v"(r) : "v"(lo), "v"(hi)); return r; }
typedef float f32x2 __attribute__((ext_vector_type(2)));
constexpr float RMS_EPS = 1e-6f;
__device__ __forceinline__ float row_rs(const float* ssq, int row) {
    const f32x4* p = (const f32x4*)(ssq + (size_t)row * 16);
    const f32x4 a = p[0], b = p[1], c = p[2], d = p[3];
    const float s = ((a[0] + a[1]) + (a[2] + a[3])) + ((b[0] + b[1]) + (b[2] + b[3])) + ((c[0] + c[1]) + (c[2] + c[3])) + ((d[0] + d[1]) + (d[2] + d[3]));
    return __builtin_amdgcn_rsqf(s * (1.0f / 1024.0f) + RMS_EPS);
}
struct EpiScaleBf16 {
    static constexpr bool PERM = true, AFTER_DRAIN = false;
    bf16_t* O; int ldc; const float* ssq; int ACT;
    __device__ __forceinline__ void operator()(const f32x4 (&acc)[2][2][4][2], const Unit& u, int wr, int wc, int fr, int fq) const {
        const int row0 = u.pm * BM + wr * 64 + fr, col0 = u.pn * BM + wc * 32 + 8 * fq;
#pragma unroll
        for (int ai = 0; ai < 2; ++ai)
#pragma unroll
            for (int m = 0; m < 4; ++m) { const int row = row0 + ai * HALF + m * 16; const float rs = row_rs(ssq, row); bf16_t* rowp = O + (size_t)row * ldc + col0;
#pragma unroll
                for (int bj = 0; bj < 2; ++bj) { f32x4 v0 = acc[ai][bj][m][0] * rs, v1 = acc[ai][bj][m][1] * rs;
                    if (ACT == 1) {
#pragma unroll
                        for (int j = 0; j < 4; ++j) { const float a = fmaxf(v0[j], 0.f), b = fmaxf(v1[j], 0.f); v0[j] = a * a; v1[j] = b * b; } }
                    u32x4 w; w.x = cvt_pk_bf16(v0[0], v0[1]); w.y = cvt_pk_bf16(v0[2], v0[3]); w.z = cvt_pk_bf16(v1[0], v1[1]); w.w = cvt_pk_bf16(v1[2], v1[3]);
                    *(u32x4*)(rowp + bj * HALF) = w; } }
    }
};
struct EpiResid {
    static constexpr bool PERM = false, AFTER_DRAIN = false;
    const float* xold; float* xout; bf16_t* xng; const float* g; float* ssq;
    __device__ __forceinline__ void operator()(const f32x4 (&acc)[2][2][4][2], const Unit& u, int wr, int wc, int fr, int fq) const {
        typedef unsigned u32x2v __attribute__((ext_vector_type(2)));
        const int row0 = u.pm * BM + wr * 64 + fr, col0 = u.pn * BM + wc * 32 + 4 * fq;
        f32x4 gv[2][2];
#pragma unroll
        for (int bj = 0; bj < 2; ++bj)
#pragma unroll
            for (int n = 0; n < 2; ++n) gv[bj][n] = xng ? *(const f32x4*)(g + col0 + bj * HALF + n * 16) : (f32x4){0.f, 0.f, 0.f, 0.f};
#pragma unroll
        for (int ai = 0; ai < 2; ++ai)
#pragma unroll
            for (int m = 0; m < 4; ++m) { const int row = row0 + ai * HALF + m * 16; const size_t off = (size_t)row * 1024 + col0; float sq = 0.f;
#pragma unroll
                for (int bj = 0; bj < 2; ++bj)
#pragma unroll
                    for (int n = 0; n < 2; ++n) { const f32x4 xo = *(const f32x4*)(xold + off + bj * HALF + n * 16); const f32x4 xn = xo + acc[ai][bj][m][n];
                        *(f32x4*)(xout + off + bj * HALF + n * 16) = xn;
                        if (xng) { sq += (xn[0] * xn[0] + xn[1] * xn[1]) + (xn[2] * xn[2] + xn[3] * xn[3]); const f32x4 y = xn * gv[bj][n];
                            u32x2v w; w.x = cvt_pk_bf16(y[0], y[1]); w.y = cvt_pk_bf16(y[2], y[3]); *(u32x2v*)(xng + off + bj * HALF + n * 16) = w; } }
                if (xng) { sq += __shfl_xor(sq, 16); sq += __shfl_xor(sq, 32); if (fq == 0) ssq[(size_t)row * 16 + u.pn * 4 + wc] = sq; }
                if (m & 1) asm volatile("" ::: "memory"); }
    }
};

template <class Epi, class Sched, bool ALIGN_EPI = false, bool SP2 = false>
__device__ __forceinline__ void gemm_phase(PG8_LAS unsigned char* lds, const Gemm g, const Sched& S, const Epi& E) {
    int tid_ = threadIdx.x; asm volatile("" : "+v"(tid_));
    const int tid = tid_, wid = __builtin_amdgcn_readfirstlane(tid >> 6), lane = tid & 63, wr = wid >> 2, wc = wid & 3, fr = lane & 15, fq = lane >> 4;
    const int K = g.K, nt = K / BK;
    unsigned voffA[2], voffB[2];
#pragma unroll
    for (int i = 0; i < 2; ++i) { int R, C; stage_rc(tid * 16 + i * 8192, R, C); const int Rb = Epi::PERM ? ((R & ~31) + perm32(R & 31)) : R;
        voffA[i] = (unsigned)(R * K + C) * 2u; voffB[i] = (unsigned)(Rb * K + C) * 2u; }
    const size_t kstep = (size_t)(BK * 2);
    const size_t hstep = (size_t)HALF * K * 2;
    const size_t tstep = 2 * hstep;
    const unsigned ldsw = (unsigned)wid * 1024u;
    const int aoff = lds_byte(wr * 64 + fr, fq * 8), boff = lds_byte(wc * 32 + fr, fq * 8);
#define PG8_SA(b, h) (((b) * 2 + (h)) * HTB)
#define PG8_SB(b, h) ((4 + (b) * 2 + (h)) * HTB)
#define PG8_STAGE(bufoff, gbase, voff) do { _Pragma("unroll") for (int _i = 0; _i < 2; ++_i) \
        __builtin_amdgcn_global_load_lds((const unsigned*)((const char*)(gbase) + (voff)[_i]), (PG8_LAS unsigned*)(lds + (bufoff) + ldsw + _i * 8192), 16, 0, 0); } while (0)
#define PG8_LDA(dst, b, h) do { _Pragma("unroll") for (int m = 0; m < 4; ++m) _Pragma("unroll") for (int k = 0; k < 2; ++k) dst[m][k] = *(const PG8_LAS bf16x8*)(lds + PG8_SA(b, h) + aoff + m * 2048 + k * 1024); } while (0)
#define PG8_LDB(dst, b, h) do { _Pragma("unroll") for (int n = 0; n < 2; ++n) _Pragma("unroll") for (int k = 0; k < 2; ++k) dst[n][k] = *(const PG8_LAS bf16x8*)(lds + PG8_SB(b, h) + boff + n * 2048 + k * 1024); } while (0)
#define PG8_MMA(ai, bj, At, Bt) do { __builtin_amdgcn_s_setprio(1); _Pragma("unroll") for (int m = 0; m < 4; ++m) _Pragma("unroll") for (int n = 0; n < 2; ++n) _Pragma("unroll") for (int k = 0; k < 2; ++k) \
        acc[ai][bj][m][n] = __builtin_amdgcn_mfma_f32_16x16x32_bf16(Bt[n][k], At[m][k], acc[ai][bj][m][n], 0, 0, 0); __builtin_amdgcn_s_setprio(0); } while (0)
#define PG8_WAIT_V(n) asm volatile("s_waitcnt vmcnt(" #n ")" ::: "memory")
#define PG8_WAIT_L(n) asm volatile("s_waitcnt lgkmcnt(" #n ")" ::: "memory")
#define PG8_BAR __builtin_amdgcn_s_barrier()
#define PG8_SCHED __builtin_amdgcn_sched_barrier(0)
    Unit cur, nxt; int ui = 0;
    if (!S.next(0, cur)) return;
    f32x4 acc[2][2][4][2];
#pragma unroll
    for (int a = 0; a < 2; ++a)
#pragma unroll
        for (int b = 0; b < 2; ++b)
#pragma unroll
            for (int m = 0; m < 4; ++m)
#pragma unroll
                for (int n = 0; n < 2; ++n) acc[a][b][m][n] = (f32x4){0.f, 0.f, 0.f, 0.f};
    bf16x8 At[4][2], B0[2][2], B1[2][2];
    const char* cA = (const char*)g.A + (size_t)cur.pm * tstep; const char* cB = (const char*)g.Bt + (size_t)cur.pn * tstep;
    S.a_ready(cur);
    if constexpr (SP2) {
        PG8_STAGE(PG8_SB(0, 0), cB, voffB); PG8_STAGE(PG8_SB(0, 1), cB + hstep, voffB); PG8_STAGE(PG8_SA(0, 0), cA, voffA); PG8_STAGE(PG8_SA(0, 1), cA + hstep, voffA);
        if (wr == 1) PG8_BAR;
        PG8_WAIT_V(2); PG8_BAR;
        PG8_STAGE(PG8_SB(1, 0), cB + kstep, voffB); PG8_STAGE(PG8_SA(1, 0), cA + kstep, voffA); PG8_STAGE(PG8_SB(1, 1), cB + hstep + kstep, voffB);
        PG8_WAIT_V(6); PG8_BAR;
    } else {
        PG8_STAGE(PG8_SB(0, 0), cB, voffB); PG8_STAGE(PG8_SA(0, 0), cA, voffA); PG8_STAGE(PG8_SB(0, 1), cB + hstep, voffB); PG8_STAGE(PG8_SA(0, 1), cA + hstep, voffA);
        if (wr == 1) PG8_BAR;
        PG8_WAIT_V(4); PG8_BAR;
        PG8_STAGE(PG8_SB(1, 0), cB + kstep, voffB); PG8_STAGE(PG8_SA(1, 0), cA + kstep, voffA); PG8_STAGE(PG8_SB(1, 1), cB + hstep + kstep, voffB);
        PG8_WAIT_V(6); PG8_BAR;
    }
    for (;;) {
        const bool has_next = S.next(ui + 1, nxt);
        const char* nA = has_next ? (const char*)g.A + (size_t)nxt.pm * tstep : cA; const char* nB = has_next ? (const char*)g.Bt + (size_t)nxt.pn * tstep : cB;
        for (int t = 0; t < nt; t += 2) {
            const bool last = (t == nt - 2);
            const char* a1 = cA + (size_t)(t + 1) * kstep;
            const char* a2 = last ? nA : cA + (size_t)(t + 2) * kstep; const char* b2 = last ? nB : cB + (size_t)(t + 2) * kstep;
            const char* a3 = a2 + kstep; const char* b3 = b2 + kstep;
            if (last && has_next) S.a_ready(nxt);
            if constexpr (SP2) {
            PG8_LDB(B0, 0, 0); PG8_LDB(B1, 0, 1); PG8_SCHED; PG8_LDA(At, 0, 0); PG8_STAGE(PG8_SA(1, 1), a1 + hstep, voffA);
            PG8_WAIT_V(8); PG8_WAIT_L(0); PG8_BAR; PG8_MMA(0, 0, At, B0); PG8_MMA(0, 1, At, B1); PG8_BAR; PG8_SCHED;
            PG8_LDA(At, 0, 1); PG8_STAGE(PG8_SB(0, 0), b2, voffB); PG8_STAGE(PG8_SB(0, 1), b2 + hstep, voffB); PG8_STAGE(PG8_SA(0, 0), a2, voffA);
            PG8_WAIT_V(8); PG8_WAIT_L(0); PG8_BAR; PG8_MMA(1, 0, At, B0); PG8_MMA(1, 1, At, B1); PG8_BAR; PG8_SCHED;
            PG8_LDB(B0, 1, 0); PG8_LDB(B1, 1, 1); PG8_SCHED; PG8_LDA(At, 1, 0); PG8_STAGE(PG8_SA(0, 1), a2 + hstep, voffA);
            PG8_WAIT_V(8); PG8_WAIT_L(0); PG8_BAR; PG8_MMA(0, 0, At, B0); PG8_MMA(0, 1, At, B1); PG8_BAR; PG8_SCHED;
            PG8_LDA(At, 1, 1); PG8_STAGE(PG8_SB(1, 0), b3, voffB); PG8_STAGE(PG8_SB(1, 1), b3 + hstep, voffB); PG8_STAGE(PG8_SA(1, 0), a3, voffA);
            PG8_WAIT_V(8); PG8_WAIT_L(0); PG8_BAR; PG8_MMA(1, 0, At, B0); PG8_MMA(1, 1, At, B1); PG8_BAR; PG8_SCHED;
            } else {
            PG8_LDB(B0, 0, 0); PG8_SCHED; PG8_LDA(At, 0, 0); PG8_STAGE(PG8_SA(1, 1), a1 + hstep, voffA);
            PG8_WAIT_L(8); PG8_BAR; PG8_WAIT_L(0); PG8_MMA(0, 0, At, B0); PG8_BAR; PG8_SCHED;
            PG8_LDB(B1, 0, 1); PG8_STAGE(PG8_SB(0, 0), b2, voffB);
            PG8_BAR; PG8_WAIT_L(0); PG8_MMA(0, 1, At, B1); PG8_BAR;
            PG8_LDA(At, 0, 1); PG8_STAGE(PG8_SA(0, 0), a2, voffA);
            PG8_BAR; PG8_WAIT_L(0); PG8_MMA(1, 0, At, B0); PG8_BAR; PG8_SCHED;
            PG8_STAGE(PG8_SB(0, 1), b2 + hstep, voffB);
            PG8_WAIT_V(6); PG8_BAR; PG8_MMA(1, 1, At, B1); PG8_BAR;
            PG8_LDB(B0, 1, 0); PG8_SCHED; PG8_LDA(At, 1, 0); PG8_STAGE(PG8_SA(0, 1), a2 + hstep, voffA);
            PG8_WAIT_L(8); PG8_BAR; PG8_WAIT_L(0); PG8_MMA(0, 0, At, B0); PG8_BAR; PG8_SCHED;
            PG8_LDB(B1, 1, 1); PG8_STAGE(PG8_SB(1, 0), b3, voffB);
            PG8_BAR; PG8_WAIT_L(0); PG8_MMA(0, 1, At, B1); PG8_BAR;
            PG8_LDA(At, 1, 1); PG8_STAGE(PG8_SA(1, 0), a3, voffA);
            PG8_BAR; PG8_WAIT_L(0); PG8_MMA(1, 0, At, B0); PG8_BAR; PG8_SCHED;
            PG8_STAGE(PG8_SB(1, 1), b3 + hstep, voffB);
            PG8_WAIT_V(6); PG8_BAR; PG8_MMA(1, 1, At, B1); PG8_BAR;
            }
        }
        if constexpr (ALIGN_EPI) { if (wr == 0) PG8_BAR; }
        if constexpr (!Epi::AFTER_DRAIN) { E(acc, cur, wr, wc, fr, fq); S.done(cur); }
        if (!has_next) break;
#pragma unroll
        for (int a = 0; a < 2; ++a)
#pragma unroll
            for (int b = 0; b < 2; ++b)
#pragma unroll
                for (int m = 0; m < 4; ++m)
#pragma unroll
                    for (int n = 0; n < 2; ++n) acc[a][b][m][n] = (f32x4){0.f, 0.f, 0.f, 0.f};
        cur = nxt; cA = nA; cB = nB; ++ui;
        if constexpr (ALIGN_EPI) { if (wr == 1) PG8_BAR; }
    }
    PG8_WAIT_V(0);
    if constexpr (!ALIGN_EPI) { if (wr == 0) PG8_BAR; }
    PG8_BAR;
    if constexpr (Epi::AFTER_DRAIN) { E.fused(acc, cur, wr, wc, fr, fq, lds, wid, lane); S.done(cur); }
#undef PG8_SA
#undef PG8_SB
#undef PG8_STAGE
#undef PG8_LDA
#undef PG8_LDB
#undef PG8_MMA
#undef PG8_WAIT_V
#undef PG8_WAIT_L
#undef PG8_BAR
#undef PG8_SCHED
}
}
#ifndef PG8_SP2
#define PG8_SP2 true
#endif
#ifndef PG8_ALIGN
#define PG8_ALIGN true
#endif

constexpr int NWAVES = 8;
constexpr int BATCH = 8, SEQ = 4096, DM = 1024, DEPTH = 2, M = BATCH * SEQ;
constexpr int HD = 64, SBH = 4, SBW = 256, RH = 8, RW = 512, CW = 256, CK = 31, DFF = 4096, INC = 3328;
constexpr float EPS = 1e-6f;
constexpr size_t MiB = 1u << 20;
constexpr size_t WS_CTL = 0, CTL_ZERO_BYTES = 1 * MiB;
constexpr size_t WS_W = 2 * MiB, W_LAYER = 25 * MiB, W_IN = 0, W_OUT = 7 * MiB, W_1 = 9 * MiB, W_2 = 17 * MiB;
constexpr size_t WS_ROT = 52 * MiB;
constexpr size_t WS_SSQ = 53 * MiB;
constexpr size_t WS_XNG = 56 * MiB;
constexpr size_t WS_RG = 56 * MiB;
constexpr size_t WS_R = 120 * MiB;
constexpr size_t WS_U = WS_R, WS_MIX = WS_R, WS_F = WS_R;
constexpr size_t WS_QS = 328 * MiB, WS_KS = 344 * MiB, WS_VS = 360 * MiB;
constexpr size_t WS_RQ = 376 * MiB, WS_RK = 408 * MiB, WS_RV = 440 * MiB;
constexpr size_t WS_HC = 472 * MiB;
constexpr size_t WS_END = 488 * MiB;
static_assert(WS_U + (size_t)M * INC * 2 <= WS_QS && WS_F + (size_t)M * DFF * 2 <= WS_HC && WS_HC + (size_t)M * CW * 2 <= WS_END, "d_ws map");
constexpr int CW_BAR = 4096;
constexpr int RING_OFF = 0, RING_BYTES = 131072, LDSCTL_OFF = RING_BYTES, MISC_OFF = LDSCTL_OFF + 320, LDS_BYTES = 147456;

#define GAS __attribute__((address_space(1)))
#define LAS __attribute__((address_space(3)))
typedef unsigned short bf16;
typedef unsigned v4u __attribute__((ext_vector_type(4)));
typedef unsigned v2u __attribute__((ext_vector_type(2)));
typedef float f32x4 __attribute__((ext_vector_type(4)));
#define LDS_WAIT() asm volatile("s_waitcnt lgkmcnt(0)" ::: "memory")
#define VM_WAIT() asm volatile("s_waitcnt vmcnt(0)" ::: "memory")
__device__ __forceinline__ float bf2f(unsigned h) { return __uint_as_float(h << 16); }
__device__ __forceinline__ float bflo(unsigned w) { return __uint_as_float(w << 16); }
__device__ __forceinline__ float bfhi(unsigned w) { return __uint_as_float(w & 0xffff0000u); }
__device__ __forceinline__ unsigned pk2(float lo, float hi) { return pg8::cvt_pk_bf16(lo, hi); }
__device__ __forceinline__ float wave_sum(float v) {
#pragma unroll
    for (int o = 1; o < 64; o <<= 1) v += __shfl_xor(v, o);
    return v;
}

struct Args {
    const float* x; const float* mix_g; const float* w_in; const float* sbq_g; const float* sbk_g; const float* ret_g; const float* pw_b; const float* dw_w; const float* dw_b;
    const float* ln_g; const float* ln_b; const float* w_out; const float* mlp_g; const float* w_ff1; const float* w_ff2;
    float* out; unsigned char* ws;
    double inv_freq[32];
    float ret_gamma[8];
    int ph_lo, ph_hi;
};

struct Frame {
    LAS unsigned char* lds;
    int tid, lane, wave, gw;
    unsigned char* ws;
};

__device__ __forceinline__ void p0_transpose_item(const float* W, int K, int N, bf16* WT, LAS float* scr, int item, int lane) {
    const int nblk = N / 32, kb = item / nblk, nb = item % nblk, k0 = 64 * kb, n0 = 32 * nb;
#pragma unroll 8
    for (int i = 0; i < 32; ++i) { const int kk = 2 * i + (lane >> 5); scr[kk * 33 + (lane & 31)] = W[(size_t)(k0 + kk) * N + n0 + (lane & 31)]; }
    LDS_WAIT(); asm volatile("" ::: "memory");
    const int c = lane & 7;
#pragma unroll
    for (int j = 0; j < 4; ++j) { const int n = (lane >> 3) + 8 * j; const LAS float* s = scr + (8 * c) * 33 + n;
        v4u o; o.x = pk2(s[0 * 33], s[1 * 33]); o.y = pk2(s[2 * 33], s[3 * 33]); o.z = pk2(s[4 * 33], s[5 * 33]); o.w = pk2(s[6 * 33], s[7 * 33]);
        *(v4u*)(WT + (size_t)(n0 + n) * K + k0 + 8 * c) = o; }
    LDS_WAIT(); asm volatile("" ::: "memory");
}
__device__ __forceinline__ void xng_row(const float* xrow, const float* g, bf16* orow, float* ssqrow, int lane) {
    const f32x4* xr = (const f32x4*)xrow + lane; const f32x4* gr = (const f32x4*)g + lane;
    f32x4 v[4]; float s = 0.f;
#pragma unroll
    for (int j = 0; j < 4; ++j) { v[j] = xr[64 * j]; s += (v[j][0] * v[j][0] + v[j][1] * v[j][1]) + (v[j][2] * v[j][2] + v[j][3] * v[j][3]); }
    s = wave_sum(s);
    v2u* o8 = (v2u*)orow + lane;
#pragma unroll
    for (int j = 0; j < 4; ++j) { const f32x4 y = v[j] * gr[64 * j]; v2u w; w.x = pk2(y[0], y[1]); w.y = pk2(y[2], y[3]); o8[64 * j] = w; }
    if (lane < 16) ssqrow[lane] = lane == 0 ? s : 0.f;
}
__device__ __forceinline__ void p0_prologue(Frame& F, const Args& A) {
    LAS float* scr = (LAS float*)(F.lds + RING_OFF + F.wave * 16384);
    const int NGW = gridDim.x * NWAVES;
    constexpr int I_IN = (DM / 64) * (INC / 32), I_OUT = (DM / 64) * (DM / 32), I_1 = (DM / 64) * (DFF / 32), I_2 = (DFF / 64) * (DM / 32), I_L = I_IN + I_OUT + I_1 + I_2;
    for (int it = F.gw; it < DEPTH * I_L; it += NGW) {
        const int l = it / I_L; int r = it % I_L; unsigned char* wl = F.ws + WS_W + (size_t)l * W_LAYER;
        if (r < I_IN) { p0_transpose_item(A.w_in + (size_t)l * DM * INC, DM, INC, (bf16*)(wl + W_IN), scr, r, F.lane); continue; } r -= I_IN;
        if (r < I_OUT) { p0_transpose_item(A.w_out + (size_t)l * DM * DM, DM, DM, (bf16*)(wl + W_OUT), scr, r, F.lane); continue; } r -= I_OUT;
        if (r < I_1) { p0_transpose_item(A.w_ff1 + (size_t)l * DM * DFF, DM, DFF, (bf16*)(wl + W_1), scr, r, F.lane); continue; } r -= I_1;
        p0_transpose_item(A.w_ff2 + (size_t)l * DFF * DM, DFF, DM, (bf16*)(wl + W_2), scr, r, F.lane);
    }
    { float2* rot = (float2*)(F.ws + WS_ROT); const int gt = F.gw * 64 + F.lane;
      for (int e = gt; e < SEQ * 32; e += NGW * 64) { const int t = e >> 5, i = e & 31; double r = (double)t * A.inv_freq[i] * 0.15915494309189535; r -= floor(r); const float fr = (float)r;
          rot[e] = make_float2(__builtin_amdgcn_cosf(fr), __builtin_amdgcn_sinf(fr)); } }
    for (int m = F.gw; m < M; m += NGW) xng_row(A.x + (size_t)m * DM, A.mix_g, (bf16*)(F.ws + WS_XNG) + (size_t)m * DM, (float*)(F.ws + WS_SSQ) + (size_t)m * 16, F.lane);
}

__device__ __forceinline__ float sigmoidf_(float x) { return 1.0f / (1.0f + __expf(-x)); }
__device__ __forceinline__ void post_phase(Frame& F, const Args& A, int l) {
    const int NGW = gridDim.x * NWAVES, lane = F.lane;
    const bf16* U = (const bf16*)(F.ws + WS_U);
    bf16 *Qs = (bf16*)(F.ws + WS_QS), *Ks = (bf16*)(F.ws + WS_KS), *Vs = (bf16*)(F.ws + WS_VS), *Rq = (bf16*)(F.ws + WS_RQ), *Rk = (bf16*)(F.ws + WS_RK), *Rv = (bf16*)(F.ws + WS_RV),
         *Rg = (bf16*)(F.ws + WS_RG), *Hc = (bf16*)(F.ws + WS_HC);
    const float2* rot = (const float2*)(F.ws + WS_ROT);
    const float* gq = A.sbq_g + l * HD; const float* gk = A.sbk_g + l * HD; const float* pwb = A.pw_b + l * 2 * CW;
    for (int row = F.gw; row < M; row += NGW) {
        const int b = row / SEQ, t = row % SEQ; const bf16* u = U + (size_t)row * INC;
        { const int hh = lane >> 4, d0 = (4 * lane) & 63; const size_t dst = ((size_t)(b * SBH + hh) * SEQ + t) * HD + d0;
#pragma unroll
          for (int w = 0; w < 2; ++w) { const v2u raw = *(const v2u*)(u + w * SBW + 4 * lane); float x0 = bflo(raw.x), x1 = bfhi(raw.x), x2 = bflo(raw.y), x3 = bfhi(raw.y);
              float ss = (x0 * x0 + x1 * x1) + (x2 * x2 + x3 * x3); ss += __shfl_xor(ss, 1); ss += __shfl_xor(ss, 2); ss += __shfl_xor(ss, 4); ss += __shfl_xor(ss, 8);
              const float r = __builtin_amdgcn_rsqf(ss * (1.0f / 64.0f) + EPS); const f32x4 g = *(const f32x4*)((w ? gk : gq) + d0);
              v2u o; o.x = pk2(x0 * r * g[0], x1 * r * g[1]); o.y = pk2(x2 * r * g[2], x3 * r * g[3]); *(v2u*)((w ? Ks : Qs) + dst) = o; }
          *(v2u*)(Vs + dst) = *(const v2u*)(u + 2 * SBW + 4 * lane); }
        { const int hh = lane >> 3, d0 = (8 * lane) & 63; const size_t dst = ((size_t)(b * RH + hh) * SEQ + t) * HD + d0;
          float2 cs[4];
#pragma unroll
          for (int p = 0; p < 4; ++p) cs[p] = rot[t * 32 + (d0 >> 1) + p];
#pragma unroll
          for (int w = 0; w < 2; ++w) { const v4u raw = *(const v4u*)(u + 3 * SBW + w * RW + 8 * lane); const float sc = w ? 0.125f : 1.0f; unsigned o[4];
#pragma unroll
              for (int p = 0; p < 4; ++p) { const float x1 = bflo(raw[p]), x2 = bfhi(raw[p]); o[p] = pk2((x1 * cs[p].x - x2 * cs[p].y) * sc, (x1 * cs[p].y + x2 * cs[p].x) * sc); }
              *(v4u*)((w ? Rk : Rq) + dst) = (v4u){o[0], o[1], o[2], o[3]}; }
          *(v4u*)(Rv + dst) = *(const v4u*)(u + 3 * SBW + 2 * RW + 8 * lane);
          { const v4u raw = *(const v4u*)(u + 3 * SBW + 3 * RW + 8 * lane); unsigned o[4];
#pragma unroll
            for (int p = 0; p < 4; ++p) { const float x1 = bflo(raw[p]), x2 = bfhi(raw[p]); o[p] = pk2(x1 * sigmoidf_(x1), x2 * sigmoidf_(x2)); }
            *(v4u*)(Rg + (size_t)row * RW + 8 * lane) = (v4u){o[0], o[1], o[2], o[3]}; } }
        { const int c0 = 4 * lane; const v2u ra = *(const v2u*)(u + 3 * SBW + 4 * RW + c0), rg = *(const v2u*)(u + 3 * SBW + 4 * RW + CW + c0);
          const f32x4 ba = *(const f32x4*)(pwb + c0), bg = *(const f32x4*)(pwb + CW + c0);
          const float h0 = (bflo(ra.x) + ba[0]) * sigmoidf_(bflo(rg.x) + bg[0]), h1 = (bfhi(ra.x) + ba[1]) * sigmoidf_(bfhi(rg.x) + bg[1]);
          const float h2 = (bflo(ra.y) + ba[2]) * sigmoidf_(bflo(rg.y) + bg[2]), h3 = (bfhi(ra.y) + ba[3]) * sigmoidf_(bfhi(rg.y) + bg[3]);
          v2u o; o.x = pk2(h0, h1); o.y = pk2(h2, h3); *(v2u*)(Hc + (size_t)row * CW + c0) = o; }
    }
}

__device__ __forceinline__ void sb_naive(Frame& F, const Args& A) {
    const int lane = F.lane; const int gw = F.gw;
    const bf16 *Qs = (const bf16*)(F.ws + WS_QS), *Ks = (const bf16*)(F.ws + WS_KS), *Vs = (const bf16*)(F.ws + WS_VS); bf16* MIX = (bf16*)(F.ws + WS_MIX);
    if (gw >= 2048) return;
    for (int it = 0; it < 64; ++it) {
        const int bh = it >> 1, t = (it & 1) ? (SEQ - 1 - gw) : gw;
        const size_t hb = (size_t)bh * SEQ * HD;
        float q[64];
        { const v4u* qp = (const v4u*)(Qs + hb + (size_t)t * HD);
#pragma unroll
          for (int i = 0; i < 8; ++i) { const v4u w = qp[i];
#pragma unroll
              for (int j = 0; j < 4; ++j) { q[8 * i + 2 * j] = bflo(w[j]); q[8 * i + 2 * j + 1] = bfhi(w[j]); } } }
        float carry = 0.f, o = 0.f;
        for (int kb = (t - 1) >> 6; kb >= 0 && t > 0; --kb) {
            const int key = kb * 64 + lane; const bool valid = key < t;
            const v4u* kp = (const v4u*)(Ks + hb + (size_t)key * HD); float z = 0.f;
#pragma unroll
            for (int i = 0; i < 8; ++i) { const v4u w = kp[i];
#pragma unroll
                for (int j = 0; j < 4; ++j) { z += q[8 * i + 2 * j] * bflo(w[j]); z += q[8 * i + 2 * j + 1] * bfhi(w[j]); } }
            z *= 0.125f;
            const float sp = fmaxf(z, 0.f) + log1pf(__expf(-fabsf(z)));
            const float lk = valid ? -sp : 0.f, lb = z - sp;
            float inc = lk;
#pragma unroll
            for (int off = 1; off < 64; off <<= 1) { const float v = __shfl_down(inc, off); if (lane + off < 64) inc += v; }
            const float tail = inc - lk + carry;
            const float w = valid ? __expf(lb + tail) : 0.f;
            carry += __shfl(inc, 0);
            const bf16* vp = Vs + hb + (size_t)(kb * 64) * HD + lane;
#pragma unroll 8
            for (int j = 0; j < 64; ++j) o += __shfl(w, j) * bf2f(vp[(size_t)j * HD]);
        }
        const int b = bh >> 2, hh = bh & 3;
        MIX[((size_t)b * SEQ + t) * DM + hh * HD + lane] = (bf16)(pk2(o, 0.f) & 0xffffu);
    }
}
__device__ __forceinline__ void ret_naive(Frame& F, const Args& A, int l) {
    const int lane = F.lane; const int gw = F.gw; if (gw >= BATCH * RH) return;
    const int b = gw / RH, hh = gw % RH; const float gamma = A.ret_gamma[hh];
    const bf16 *Rq = (const bf16*)(F.ws + WS_RQ), *Rk = (const bf16*)(F.ws + WS_RK), *Rv = (const bf16*)(F.ws + WS_RV), *Rg = (const bf16*)(F.ws + WS_RG); bf16* MIX = (bf16*)(F.ws + WS_MIX);
    const size_t hb = (size_t)gw * SEQ * HD; const float gn = A.ret_g[l * RW + hh * HD + lane];
    float S[64];
#pragma unroll
    for (int d = 0; d < 64; ++d) S[d] = 0.f;
    for (int t = 0; t < SEQ; ++t) {
        const v4u* qp = (const v4u*)(Rq + hb + (size_t)t * HD); const v4u* kp = (const v4u*)(Rk + hb + (size_t)t * HD);
        const float v = bf2f(Rv[hb + (size_t)t * HD + lane]); float o = 0.f;
#pragma unroll
        for (int i = 0; i < 8; ++i) { const v4u qw = qp[i], kw = kp[i];
#pragma unroll
            for (int j = 0; j < 4; ++j) { const int d = 8 * i + 2 * j;
                S[d] = S[d] * gamma + bflo(kw[j]) * v; o += bflo(qw[j]) * S[d];
                S[d + 1] = S[d + 1] * gamma + bfhi(kw[j]) * v; o += bfhi(qw[j]) * S[d + 1]; } }
        const float ss = wave_sum(o * o); const float r = o * __builtin_amdgcn_rsqf(ss * (1.0f / 64.0f) + EPS) * gn;
        const size_t row = (size_t)b * SEQ + t; const float gt = bf2f(Rg[row * RW + hh * HD + lane]);
        MIX[row * DM + SBW + hh * HD + lane] = (bf16)(pk2(gt * r, 0.f) & 0xffffu);
    }
}
__device__ __forceinline__ void conv_naive(Frame& F, const Args& A, int l) {
    const int tid = F.tid, c = tid & 255, half = tid >> 8; LAS float* red = (LAS float*)(F.lds + RING_OFF);
    const bf16* Hc = (const bf16*)(F.ws + WS_HC); bf16* MIX = (bf16*)(F.ws + WS_MIX);
    const float* dww = A.dw_w + (size_t)l * CK * CW; const float dwb = A.dw_b[l * CW + c], lg = A.ln_g[l * CW + c], lb = A.ln_b[l * CW + c];
    float w[CK];
#pragma unroll
    for (int j = 0; j < CK; ++j) w[j] = dww[j * CW + c];
    for (int tok = blockIdx.x * 2 + half; tok < M; tok += gridDim.x * 2) {
        const int t = tok % SEQ; float acc = dwb;
#pragma unroll
        for (int j = 0; j < CK; ++j) { const int tt = t - (CK - 1) + j; if (tt >= 0) acc += w[j] * bf2f(Hc[(size_t)(tok - (CK - 1) + j) * CW + c]); }
        float s = wave_sum(acc);
        if (F.lane == 0) red[(half * 4 + (F.wave & 3)) * 2] = s;
        __syncthreads();
        const float mean = (red[(half * 4 + 0) * 2] + red[(half * 4 + 1) * 2] + red[(half * 4 + 2) * 2] + red[(half * 4 + 3) * 2]) * (1.0f / 256.0f);
        const float dv = acc - mean; float s2 = wave_sum(dv * dv);
        if (F.lane == 0) red[(half * 4 + (F.wave & 3)) * 2 + 1] = s2;
        __syncthreads();
        const float var = (red[(half * 4 + 0) * 2 + 1] + red[(half * 4 + 1) * 2 + 1] + red[(half * 4 + 2) * 2 + 1] + red[(half * 4 + 3) * 2 + 1]) * (1.0f / 256.0f);
        const float y = dv * __builtin_amdgcn_rsqf(var + EPS) * lg + lb; const float o = y * sigmoidf_(y);
        MIX[(size_t)tok * DM + SBW + RW + c] = (bf16)(pk2(o, 0.f) & 0xffffu);
        __syncthreads();
    }
}

constexpr int N_PHASES = 1 + DEPTH * 8;
__global__ void __launch_bounds__(NWAVES * 64, 2) mk_fwd(Args args) {
    extern __shared__ __attribute__((aligned(16))) unsigned char lds[];
    Frame F;
    F.lds = (LAS unsigned char*)lds; F.tid = threadIdx.x; F.lane = F.tid & 63; F.wave = __builtin_amdgcn_readfirstlane(F.tid >> 6); F.gw = blockIdx.x * NWAVES + F.wave; F.ws = args.ws;
#if MK_ONE_LAUNCH
    cg::grid_group grid = cg::this_grid();
#endif
    for (int ph = args.ph_lo; ph < args.ph_hi; ++ph) {
        { int t_ = threadIdx.x; asm volatile("" : "+v"(t_)); F.tid = t_; F.lane = t_ & 63; F.wave = __builtin_amdgcn_readfirstlane(t_ >> 6); F.gw = blockIdx.x * NWAVES + F.wave; }
        const int l = ph == 0 ? 0 : (ph - 1) >> 3, kind = ph == 0 ? 0 : ((ph - 1) & 7) + 1;
        unsigned char* wl = F.ws + WS_W + (size_t)l * W_LAYER;
        if (kind == 0) p0_prologue(F, args);
        else if (kind == 1 || kind == 7) {
            const bool ff = kind == 7; const int N = ff ? DFF : INC;
            pg8::Gemm g{(const pg8::bf16_t*)(F.ws + WS_XNG), (const pg8::bf16_t*)(wl + (ff ? W_1 : W_IN)), M, N, DM}; pg8::StaticOrder S; S.init(M, N, gridDim.x, (int)blockIdx.x);
            pg8::EpiScaleBf16 E{(pg8::bf16_t*)(F.ws + (ff ? WS_F : WS_U)), N, (const float*)(F.ws + WS_SSQ), ff ? 1 : 0};
            pg8::gemm_phase<pg8::EpiScaleBf16, pg8::StaticOrder, PG8_ALIGN, PG8_SP2>(F.lds + RING_OFF, g, S, E);
        }
        else if (kind == 2) post_phase(F, args, l);
        else if (kind == 3) sb_naive(F, args);
        else if (kind == 4) ret_naive(F, args, l);
        else if (kind == 5) conv_naive(F, args, l);
        else {
            const bool ff = kind == 8; const bool more = !ff || (l + 1 < DEPTH);
            pg8::Gemm g{(const pg8::bf16_t*)(F.ws + (ff ? WS_F : WS_MIX)), (const pg8::bf16_t*)(wl + (ff ? W_2 : W_OUT)), M, DM, ff ? DFF : DM}; pg8::StaticOrder S; S.init(M, DM, gridDim.x, (int)blockIdx.x);
            const float* xin = (!ff && l == 0) ? args.x : args.out;
            const float* gg = ff ? args.mix_g + (more ? (l + 1) * DM : 0) : args.mlp_g + l * DM;
            pg8::EpiResid E{xin, args.out, more ? (pg8::bf16_t*)(F.ws + WS_XNG) : nullptr, gg, (float*)(F.ws + WS_SSQ)};
            pg8::gemm_phase<pg8::EpiResid, pg8::StaticOrder, PG8_ALIGN, PG8_SP2>(F.lds + RING_OFF, g, S, E);
        }
#if MK_ONE_LAUNCH
        if (ph + 1 < args.ph_hi) grid.sync();
#endif
    }
}

extern "C" void kernel_launch(void* const* d_in, const int* in_sizes, int n_in, void* d_out, int out_size, void* d_ws, size_t ws_size, hipStream_t stream) {
    static int grid = 0;
    if (grid == 0) {
        if (n_in != 15 || in_sizes[0] != M * DM || out_size != M * DM || ws_size < WS_END) { fprintf(stderr, "kernel_launch: unexpected shapes (n_in %d, in0 %d, out %d, ws %zu); nothing launched\n", n_in, n_in > 0 ? in_sizes[0] : -1, out_size, ws_size); grid = -1; return; }
        int dev = 0, cus = 0, per_cu = 0;
        if (hipGetDevice(&dev) != hipSuccess || hipDeviceGetAttribute(&cus, hipDeviceAttributeMultiprocessorCount, dev) != hipSuccess) { grid = -1; return; }
        if (hipFuncSetAttribute((const void*)mk_fwd, hipFuncAttributeMaxDynamicSharedMemorySize, LDS_BYTES) != hipSuccess) { fprintf(stderr, "kernel_launch: hipFuncSetAttribute failed\n"); grid = -1; return; }
        if (hipOccupancyMaxActiveBlocksPerMultiprocessor(&per_cu, (const void*)mk_fwd, NWAVES * 64, LDS_BYTES) != hipSuccess || per_cu < 1) { fprintf(stderr, "kernel_launch: occupancy query says %d blocks per CU\n", per_cu); per_cu = 1; }
        (void)hipGetLastError();
        grid = cus;
    }
    if (grid < 0) return;
    (void)hipMemsetAsync((char*)d_ws + WS_CTL, 0, CTL_ZERO_BYTES, stream);
    Args a{};
    a.x = (const float*)d_in[0]; a.mix_g = (const float*)d_in[1]; a.w_in = (const float*)d_in[2]; a.sbq_g = (const float*)d_in[3]; a.sbk_g = (const float*)d_in[4]; a.ret_g = (const float*)d_in[5];
    a.pw_b = (const float*)d_in[6]; a.dw_w = (const float*)d_in[7]; a.dw_b = (const float*)d_in[8]; a.ln_g = (const float*)d_in[9]; a.ln_b = (const float*)d_in[10]; a.w_out = (const float*)d_in[11];
    a.mlp_g = (const float*)d_in[12]; a.w_ff1 = (const float*)d_in[13]; a.w_ff2 = (const float*)d_in[14];
    a.out = (float*)d_out; a.ws = (unsigned char*)d_ws;
    for (int i = 0; i < 32; ++i) a.inv_freq[i] = 1.0 / pow(10000.0, (double)i / 31.0);
    for (int h = 0; h < 8; ++h) a.ret_gamma[h] = (float)(1.0 - exp2(-5.0 - (double)h));
#if MK_ONE_LAUNCH
    a.ph_lo = 0; a.ph_hi = N_PHASES;
    void* kargs[] = {&a};
    hipError_t e = hipLaunchCooperativeKernel((const void*)mk_fwd, dim3(grid), dim3(NWAVES * 64), kargs, LDS_BYTES, stream);
    if (e != hipSuccess) fprintf(stderr, "kernel_launch: cooperative launch failed: %s (grid %d)\n", hipGetErrorString(e), grid);
#else
    for (int p = 0; p < N_PHASES; ++p) { a.ph_lo = p; a.ph_hi = p + 1; hipLaunchKernelGGL(mk_fwd, dim3(grid), dim3(NWAVES * 64), LDS_BYTES, stream, a); }
#endif
}
```

```cpp
#include <hip/hip_runtime.h>
#include <hip/hip_cooperative_groups.h>
#include <cstdio>
#include <cstdint>
#include <cmath>
namespace cg = cooperative_groups;

#ifndef MK_ONE_LAUNCH
#define MK_ONE_LAUNCH 1
#endif
namespace pg8 {
#define PG8_LAS __attribute__((address_space(3)))
typedef unsigned short bf16_t;
typedef short bf16x8 __attribute__((ext_vector_type(8)));
typedef float f32x4 __attribute__((ext_vector_type(4)));
typedef unsigned u32x4 __attribute__((ext_vector_type(4)));
constexpr int BM = 256, BK = 64, HALF = 128, HTB = HALF * BK * 2  , STAGE_BYTES = 8 * HTB, NXCD = 8, WGM = 8;

__host__ __device__ __forceinline__ int lds_byte(int r, int c) { const int st = (r >> 4) * 2 + (c >> 5), rr = r & 15, cc = c & 31, ob = rr * 64 + cc * 2; return st * 1024 + (ob ^ (((ob >> 9) & 1) << 5)); }
__host__ __device__ __forceinline__ void stage_rc(int b, int& R, int& C) { const int st = b / 1024, sb = b % 1024, swz = sb ^ (((sb >> 9) & 1) << 5); R = (st >> 1) * 16 + swz / 64; C = (st & 1) * 32 + (swz % 64) / 2; }
__host__ __device__ __forceinline__ int perm32(int rho) { const int n = rho >> 4, i = rho & 15; return 8 * (i >> 2) + 4 * n + (i & 3); }

struct Unit { int pm, pn, idx; };
struct Gemm { const bf16_t* A; const bf16_t* Bt; int M, N, K; int a_blocked; };

struct StaticOrder {
    int nM, nN, nwg, G, c;
    __host__ __device__ void init(int M, int N, int G_, int c_) { nM = M / BM; nN = N / BM; nwg = nM * nN; G = G_; c = c_; }
    __host__ __device__ bool next(int i, Unit& u) const {
        const long L = (long)i * G + c; if (L >= nwg) return false;
        int wgid = (int)L; { const int q = nwg / NXCD, r = nwg % NXCD, xcd = wgid % NXCD, off = wgid / NXCD; wgid = (xcd < r ? xcd * (q + 1) : r * (q + 1) + (xcd - r) * q) + off; }
        const int nig = WGM * nN, gid = wgid / nig, fm = gid * WGM, gsz = (nM - fm) < WGM ? (nM - fm) : WGM;
        u.pm = fm + ((wgid % nig) % gsz); u.pn = (wgid % nig) / gsz; u.idx = i; return true;
    }
    __device__ __forceinline__ void a_ready(const Unit&) const {}
    __device__ __forceinline__ void done(const Unit&) const {}
};

typedef float f32x2c_t __attribute__((ext_vector_type(2))); typedef __bf16 bf16x2c_t __attribute__((ext_vector_type(2)));
__device__ __forceinline__ unsigned cvt_pk_bf16(float lo, float hi) { const f32x2c_t v = {lo, hi}; const bf16x2c_t b = __builtin_convertvector(v, bf16x2c_t); return __builtin_bit_cast(unsigned, b); }
typedef float f32x2 __attribute__((ext_vector_type(2)));
constexpr float RMS_EPS = 1e-6f;
constexpr int RS_OFF = 131072 + 1024;
template <class Sched> __device__ __forceinline__ void fill_rs(PG8_LAS unsigned char* lds0, const Sched& S, const float* ssq) {
    PG8_LAS float* rsl = (PG8_LAS float*)(lds0 + RS_OFF); Unit u;
#pragma unroll 1
    for (int i = 0; i < 8 && S.next(i, u); ++i) { int t = threadIdx.x; asm volatile("" : "+v"(t));
        if (t < 256) { const f32x4* p = (const f32x4*)(ssq + (size_t)(u.pm * BM + t) * 16); const f32x4 a = p[0], b = p[1], c = p[2], d = p[3];
            const float s = ((a[0] + a[1]) + (a[2] + a[3])) + ((b[0] + b[1]) + (b[2] + b[3])) + ((c[0] + c[1]) + (c[2] + c[3])) + ((d[0] + d[1]) + (d[2] + d[3]));
            rsl[i * 256 + t] = __builtin_amdgcn_rsqf(s * (1.0f / 1024.0f) + RMS_EPS); } }
    __syncthreads();
}
#define PG8_ROW_RS(lds0_, u_, row_) (((const PG8_LAS float*)((lds0_) + RS_OFF))[(u_).idx * 256 + ((row_) & 255)])
__device__ __forceinline__ u32x4 pair_swap(u32x4 x) { u32x4 y;
    y.x = (unsigned)__builtin_amdgcn_mov_dpp((int)x.x, 0xB1, 0xF, 0xF, true); y.y = (unsigned)__builtin_amdgcn_mov_dpp((int)x.y, 0xB1, 0xF, 0xF, true);
    y.z = (unsigned)__builtin_amdgcn_mov_dpp((int)x.z, 0xB1, 0xF, 0xF, true); y.w = (unsigned)__builtin_amdgcn_mov_dpp((int)x.w, 0xB1, 0xF, 0xF, true); return y; }
#define PG8_FULL_LINE(w0_, w1_, odd_, sa_, sb_) do { const u32x4 snd_ = (odd_) ? (w0_) : (w1_); const u32x4 rcv_ = pair_swap(snd_); sa_ = (odd_) ? rcv_ : (w0_); sb_ = (odd_) ? (w1_) : rcv_; } while (0)
__device__ __forceinline__ __amdgpu_buffer_rsrc_t wt_rsrc(void* base, unsigned bytes) { return __builtin_amdgcn_make_buffer_rsrc(base, 0, bytes, 0x00020000); }
__device__ __forceinline__ void st16_wt(__amdgpu_buffer_rsrc_t r, unsigned byteoff, u32x4 v) { __builtin_amdgcn_raw_buffer_store_b128(v, r, byteoff, 0,   16); }
struct EpiScaleBf16 {
    static constexpr bool PERM = true, AFTER_DRAIN = false;
    bf16_t* O; int ldc; PG8_LAS unsigned char* lds0; int ACT;
    __device__ __forceinline__ void operator()(const f32x4 (&acc)[2][2][4][2], const Unit& u, int wr, int wc, int fr, int fq) const {
        const int row0 = u.pm * BM + wr * 64 + fr; const int odd = fr & 1;
        const __amdgpu_buffer_rsrc_t orr = wt_rsrc(O, (unsigned)(32768u * (unsigned)ldc * 2u));
#pragma unroll
        for (int ai = 0; ai < 2; ++ai)
#pragma unroll
            for (int m = 0; m < 4; ++m) { const int row = row0 + ai * HALF + m * 16; const float rs = PG8_ROW_RS(lds0, u, row);
                const unsigned P = (((unsigned)(row >> 7) * (unsigned)(ldc >> 6) + (unsigned)(u.pn * 4 + wc)) * 8192u + (unsigned)(((row - odd) & 127) * 64 + 8 * fq + odd * 32)) * 2u;
                u32x4 w[2];
#pragma unroll
                for (int bj = 0; bj < 2; ++bj) { f32x4 v0 = acc[ai][bj][m][0] * rs, v1 = acc[ai][bj][m][1] * rs;
                    if (ACT == 1) {
#pragma unroll
                        for (int j = 0; j < 4; ++j) { const float a = fmaxf(v0[j], 0.f), b = fmaxf(v1[j], 0.f); v0[j] = a * a; v1[j] = b * b; } }
                    w[bj].x = cvt_pk_bf16(v0[0], v0[1]); w[bj].y = cvt_pk_bf16(v0[2], v0[3]); w[bj].z = cvt_pk_bf16(v1[0], v1[1]); w[bj].w = cvt_pk_bf16(v1[2], v1[3]); }
                u32x4 sa, sb; PG8_FULL_LINE(w[0], w[1], odd, sa, sb);
                st16_wt(orr, P, sa); st16_wt(orr, P + 128u, sb); }
    }
};
struct EpiResid {
    static constexpr bool PERM = true, AFTER_DRAIN = false;
    bf16_t* xb; float* out32; float* ssq;
    __device__ __forceinline__ void operator()(const f32x4 (&acc)[2][2][4][2], const Unit& u, int wr, int wc, int fr, int fq) const {
        const int row0 = u.pm * BM + wr * 64 + fr, col0 = u.pn * BM + wc * 64 + 8 * fq;
        const int odd = fr & 1;
#define PG8_XBOFF(row_, col_) ((size_t)(((row_) >> 7) * 16 + ((col_) >> 6)) * 8192 + ((row_) & 127) * 64 + ((col_) & 63))
#define PG8_XUNPACK(r_, x0_, x1_) \
        f32x4 x0_ = (f32x4){__uint_as_float(r_.x << 16), __uint_as_float(r_.x & 0xffff0000u), __uint_as_float(r_.y << 16), __uint_as_float(r_.y & 0xffff0000u)}; \
        f32x4 x1_ = (f32x4){__uint_as_float(r_.z << 16), __uint_as_float(r_.z & 0xffff0000u), __uint_as_float(r_.w << 16), __uint_as_float(r_.w & 0xffff0000u)};
        if (out32 == nullptr) {
#pragma unroll
            for (int ai = 0; ai < 2; ++ai) {
                u32x4 xr[4][2];
#pragma unroll
                for (int m = 0; m < 4; ++m)
#pragma unroll
                    for (int bj = 0; bj < 2; ++bj) xr[m][bj] = *(const u32x4*)(xb + PG8_XBOFF(row0 - odd + bj + ai * HALF + m * 16, col0 + odd * 32));
#pragma unroll
                for (int m = 0; m < 4; ++m) { const int row = row0 + ai * HALF + m * 16; const size_t off = (size_t)row * 1024 + col0; float sq = 0.f;
                    u32x4 xo[2], w[2]; PG8_FULL_LINE(xr[m][0], xr[m][1], odd, xo[0], xo[1]);
#pragma unroll
                    for (int bj = 0; bj < 2; ++bj) { const u32x4 r = xo[bj]; PG8_XUNPACK(r, x0, x1)
                        x0 = x0 + acc[ai][bj][m][0]; x1 = x1 + acc[ai][bj][m][1];
                        sq += ((x0[0] * x0[0] + x0[1] * x0[1]) + (x0[2] * x0[2] + x0[3] * x0[3])) + ((x1[0] * x1[0] + x1[1] * x1[1]) + (x1[2] * x1[2] + x1[3] * x1[3]));
                        w[bj].x = cvt_pk_bf16(x0[0], x0[1]); w[bj].y = cvt_pk_bf16(x0[2], x0[3]); w[bj].z = cvt_pk_bf16(x1[0], x1[1]); w[bj].w = cvt_pk_bf16(x1[2], x1[3]); }
                    { u32x4 sa, sb; PG8_FULL_LINE(w[0], w[1], odd, sa, sb); bf16_t* P = xb + PG8_XBOFF(row - odd, col0 + odd * 32); *(u32x4*)P = sa; *(u32x4*)(P + 64) = sb; }
                    sq += __shfl_xor(sq, 16); sq += __shfl_xor(sq, 32); if (fq == 0) ssq[(size_t)row * 16 + u.pn * 4 + wc] = sq; }
                asm volatile("" ::: "memory"); }
        } else {
#pragma unroll
            for (int ai = 0; ai < 2; ++ai) {
                u32x4 xr[4][2];
#pragma unroll
                for (int m = 0; m < 4; ++m)
#pragma unroll
                    for (int bj = 0; bj < 2; ++bj) xr[m][bj] = *(const u32x4*)(xb + PG8_XBOFF(row0 - odd + bj + ai * HALF + m * 16, col0 + odd * 32));
#pragma unroll
                for (int m = 0; m < 4; ++m) { const size_t off = (size_t)(row0 + ai * HALF + m * 16) * 1024 + col0; u32x4 xo[2]; PG8_FULL_LINE(xr[m][0], xr[m][1], odd, xo[0], xo[1]);
#pragma unroll
                    for (int bj = 0; bj < 2; ++bj) { const u32x4 r = xo[bj]; PG8_XUNPACK(r, x0, x1)
                        x0 = x0 + acc[ai][bj][m][0]; x1 = x1 + acc[ai][bj][m][1];
                        *(f32x4*)(out32 + off + bj * 32) = x0; *(f32x4*)(out32 + off + bj * 32 + 4) = x1; } }
                asm volatile("" ::: "memory"); }
        }
#undef PG8_XUNPACK
#undef PG8_XBOFF
    }
};

__host__ __device__ __forceinline__ int inproj_srccol(int rho) {
    const int gi = rho >> 5, tile = gi >> 3, w8 = gi & 7, wc = w8 >> 1, bj = w8 & 1;
    if (tile == 11 || tile == 12) return (bj ? 3072 : 2816) + 128 * (tile - 11) + 32 * wc;
    return rho;
}
struct EpiInProj {
    static constexpr bool PERM = true, AFTER_DRAIN = false;
    PG8_LAS unsigned char* lds0; unsigned char* ws; const float* gq; const float* gk; const float* pwb;
    size_t oQS, oKS, oVS, oRQ, oRK, oRV, oRG, oHC, oROT; float c2, eps;
    __device__ __forceinline__ void operator()(const f32x4 (&acc)[2][2][4][2], const Unit& u, int wr, int wc, int fr, int fq) const {
        const int pn = u.pn, rowb = u.pm * BM + wr * 64 + fr;
        f32x4 cv[2][2];
#pragma unroll
        for (int bj = 0; bj < 2; ++bj)
#pragma unroll
            for (int n = 0; n < 2; ++n) cv[bj][n] = (f32x4){0.f, 0.f, 0.f, 0.f};
        if (pn < 2) { const float* g = pn ? gk : gq;
#pragma unroll
            for (int bj = 0; bj < 2; ++bj)
#pragma unroll
                for (int n = 0; n < 2; ++n) cv[bj][n] = *(const f32x4*)(g + 32 * bj + 8 * fq + 4 * n); }
        else if (pn >= 11) {
#pragma unroll
            for (int bj = 0; bj < 2; ++bj)
#pragma unroll
                for (int n = 0; n < 2; ++n) cv[bj][n] = *(const f32x4*)(pwb + 256 * bj + 128 * (pn - 11) + 32 * wc + 8 * fq + 4 * n); }
        float ifr[2][4];
#pragma unroll
        for (int bj = 0; bj < 2; ++bj)
#pragma unroll
            for (int p = 0; p < 4; ++p) ifr[bj][p] = __builtin_amdgcn_exp2f(-(float)(16 * bj + 4 * fq + p) * (13.287712379549449f / 31.0f)) * 0.15915494309189535f;
#pragma unroll
        for (int ai = 0; ai < 2; ++ai)
#pragma unroll
            for (int m = 0; m < 4; ++m) {
                const int row = rowb + ai * HALF + m * 16, b = row >> 12, t = row & 4095; const float rs = PG8_ROW_RS(lds0, u, row);
                f32x4 v[2][2];
#pragma unroll
                for (int bj = 0; bj < 2; ++bj)
#pragma unroll
                    for (int n = 0; n < 2; ++n) v[bj][n] = acc[ai][bj][m][n] * rs;
                if (pn < 2) {
                    float ss = 0.f;
#pragma unroll
                    for (int bj = 0; bj < 2; ++bj)
#pragma unroll
                        for (int n = 0; n < 2; ++n) ss += (v[bj][n][0] * v[bj][n][0] + v[bj][n][1] * v[bj][n][1]) + (v[bj][n][2] * v[bj][n][2] + v[bj][n][3] * v[bj][n][3]);
                    ss += __shfl_xor(ss, 16); ss += __shfl_xor(ss, 32);
                    float r = __builtin_amdgcn_rsqf(ss * (1.0f / 64.0f) + eps); if (pn == 0) r *= c2;
                    bf16_t* dst = (bf16_t*)(ws + (pn ? oKS : oQS)) + ((size_t)(b * 4 + wc) * 4096 + t) * 64 + 8 * fq;
#pragma unroll
                    for (int bj = 0; bj < 2; ++bj) { const f32x4 y0 = v[bj][0] * r * cv[bj][0], y1 = v[bj][1] * r * cv[bj][1];
                        u32x4 w; w.x = cvt_pk_bf16(y0[0], y0[1]); w.y = cvt_pk_bf16(y0[2], y0[3]); w.z = cvt_pk_bf16(y1[0], y1[1]); w.w = cvt_pk_bf16(y1[2], y1[3]); *(u32x4*)(dst + 32 * bj) = w; }
                } else if (pn == 2) {
#pragma unroll
                    for (int bj = 0; bj < 2; ++bj) { bf16_t* dst = (bf16_t*)(ws + oVS) + ((size_t)(b * 4 + wc) * 4096 + t) * 64 + 32 * bj + 8 * fq;
                        u32x4 w; w.x = cvt_pk_bf16(v[bj][0][0], v[bj][0][1]); w.y = cvt_pk_bf16(v[bj][0][2], v[bj][0][3]); w.z = cvt_pk_bf16(v[bj][1][0], v[bj][1][1]); w.w = cvt_pk_bf16(v[bj][1][2], v[bj][1][3]); *(u32x4*)dst = w; }
                } else if (pn < 7) {
                    const float sc = pn >= 5 ? 0.125f : 1.0f; const int head = 4 * ((pn - 3) & 1) + wc; const float tf = (float)t;
#pragma unroll
                    for (int bj = 0; bj < 2; ++bj) { float cs[4], sn[4];
#pragma unroll
                        for (int p = 0; p < 4; ++p) { const float rev = __builtin_amdgcn_fractf(tf * ifr[bj][p]); cs[p] = __builtin_amdgcn_cosf(rev) * sc; sn[p] = __builtin_amdgcn_sinf(rev) * sc; }
                        bf16_t* dst = (bf16_t*)(ws + (pn >= 5 ? oRK : oRQ)) + ((size_t)(b * 8 + head) * 4096 + t) * 64 + 32 * bj + 8 * fq;
                        const f32x4 a = v[bj][0], c = v[bj][1]; u32x4 w;
                        w.x = cvt_pk_bf16(a[0] * cs[0] - a[1] * sn[0], a[0] * sn[0] + a[1] * cs[0]); w.y = cvt_pk_bf16(a[2] * cs[1] - a[3] * sn[1], a[2] * sn[1] + a[3] * cs[1]);
                        w.z = cvt_pk_bf16(c[0] * cs[2] - c[1] * sn[2], c[0] * sn[2] + c[1] * cs[2]); w.w = cvt_pk_bf16(c[2] * cs[3] - c[3] * sn[3], c[2] * sn[3] + c[3] * cs[3]);
                        *(u32x4*)dst = w; }
                } else if (pn < 9) {
                    const int head = 4 * (pn - 7) + wc; const float lg2 = __builtin_amdgcn_logf(1.0f - __builtin_amdgcn_exp2f(-5.0f - (float)head)); const float sc = __builtin_amdgcn_exp2f(-(float)(t & 63) * lg2);
#pragma unroll
                    for (int bj = 0; bj < 2; ++bj) { bf16_t* dst = (bf16_t*)(ws + oRV) + ((size_t)(b * 8 + head) * 4096 + t) * 64 + 32 * bj + 8 * fq; const f32x4 a = v[bj][0] * sc, c = v[bj][1] * sc;
                        u32x4 w; w.x = cvt_pk_bf16(a[0], a[1]); w.y = cvt_pk_bf16(a[2], a[3]); w.z = cvt_pk_bf16(c[0], c[1]); w.w = cvt_pk_bf16(c[2], c[3]); *(u32x4*)dst = w; }
                } else if (pn < 11) {
#pragma unroll
                    for (int bj = 0; bj < 2; ++bj) { bf16_t* dst = (bf16_t*)(ws + oRG) + (size_t)row * 512 + 256 * (pn - 9) + 64 * wc + 32 * bj + 8 * fq; f32x4 a = v[bj][0], c = v[bj][1];
#pragma unroll
                        for (int j = 0; j < 4; ++j) { a[j] = a[j] * __builtin_amdgcn_rcpf(1.0f + __builtin_amdgcn_exp2f(-1.4426950408889634f * a[j])); c[j] = c[j] * __builtin_amdgcn_rcpf(1.0f + __builtin_amdgcn_exp2f(-1.4426950408889634f * c[j])); }
                        u32x4 w; w.x = cvt_pk_bf16(a[0], a[1]); w.y = cvt_pk_bf16(a[2], a[3]); w.z = cvt_pk_bf16(c[0], c[1]); w.w = cvt_pk_bf16(c[2], c[3]); *(u32x4*)dst = w; }
                } else {
                    bf16_t* dst = (bf16_t*)(ws + oHC) + (size_t)row * 256 + 128 * (pn - 11) + 32 * wc + 8 * fq; f32x4 h[2];
#pragma unroll
                    for (int n = 0; n < 2; ++n) { const f32x4 a = v[0][n] + cv[0][n], g = v[1][n] + cv[1][n];
#pragma unroll
                        for (int j = 0; j < 4; ++j) h[n][j] = a[j] * __builtin_amdgcn_rcpf(1.0f + __builtin_amdgcn_exp2f(-1.4426950408889634f * g[j])); }
                    u32x4 w; w.x = cvt_pk_bf16(h[0][0], h[0][1]); w.y = cvt_pk_bf16(h[0][2], h[0][3]); w.z = cvt_pk_bf16(h[1][0], h[1][1]); w.w = cvt_pk_bf16(h[1][2], h[1][3]); *(u32x4*)dst = w;
                }
            }
    }
};

template <class Epi, class Sched, bool ALIGN_EPI = false, bool SP2 = false>
__device__ __forceinline__ void gemm_phase(PG8_LAS unsigned char* lds, const Gemm g, const Sched& S, const Epi& E) {
    int tid_ = threadIdx.x; asm volatile("" : "+v"(tid_));
    const int tid = tid_, wid = __builtin_amdgcn_readfirstlane(tid >> 6), lane = tid & 63, wr = wid >> 2, wc = wid & 3, fr = lane & 15, fq = lane >> 4;
    const int K = g.K, nt = K / BK;
    unsigned voffA[2], voffB[2];
#pragma unroll
    for (int i = 0; i < 2; ++i) { int R, C; stage_rc(tid * 16 + i * 8192, R, C); const int Rb = Epi::PERM ? (64 * (R >> 5) + perm32(R & 31)) : R;
        voffA[i] = (unsigned)(R * (g.a_blocked ? BK : K) + C) * 2u; voffB[i] = (unsigned)(Rb * K + C) * 2u; }
    const size_t kstep = (size_t)(BK * 2);
    const size_t hstep = (size_t)HALF * K * 2;
    const size_t tstep = 2 * hstep;
    const size_t hstepB = Epi::PERM ? (size_t)32 * K * 2 : hstep;
    const size_t kstepA = g.a_blocked ? (size_t)(HALF * BK * 2) : kstep, hstepA = g.a_blocked ? (size_t)(K / BK) * (HALF * BK * 2) : hstep, tstepA = 2 * hstepA;
    const unsigned ldsw = (unsigned)wid * 1024u;
    const int aoff = lds_byte(wr * 64 + fr, fq * 8), boff = lds_byte(wc * 32 + fr, fq * 8);
#define PG8_SA(b, h) (((b) * 2 + (h)) * HTB)
#define PG8_SB(b, h) ((4 + (b) * 2 + (h)) * HTB)
#define PG8_STAGE(bufoff, gbase, voff) do { _Pragma("unroll") for (int _i = 0; _i < 2; ++_i) \
        __builtin_amdgcn_global_load_lds((const unsigned*)((const char*)(gbase) + (voff)[_i]), (PG8_LAS unsigned*)(lds + (bufoff) + ldsw + _i * 8192), 16, 0, 0); } while (0)
#define PG8_LDA(dst, b, h) do { _Pragma("unroll") for (int m = 0; m < 4; ++m) _Pragma("unroll") for (int k = 0; k < 2; ++k) dst[m][k] = *(const PG8_LAS bf16x8*)(lds + PG8_SA(b, h) + aoff + m * 2048 + k * 1024); } while (0)
#define PG8_LDB(dst, b, h) do { _Pragma("unroll") for (int n = 0; n < 2; ++n) _Pragma("unroll") for (int k = 0; k < 2; ++k) dst[n][k] = *(const PG8_LAS bf16x8*)(lds + PG8_SB(b, h) + boff + n * 2048 + k * 1024); } while (0)
#define PG8_MMA(ai, bj, At, Bt) do { __builtin_amdgcn_s_setprio(1); _Pragma("unroll") for (int m = 0; m < 4; ++m) _Pragma("unroll") for (int n = 0; n < 2; ++n) _Pragma("unroll") for (int k = 0; k < 2; ++k) \
        acc[ai][bj][m][n] = __builtin_amdgcn_mfma_f32_16x16x32_bf16(Bt[n][k], At[m][k], acc[ai][bj][m][n], 0, 0, 0); __builtin_amdgcn_s_setprio(0); } while (0)
#define PG8_WAIT_V(n) asm volatile("s_waitcnt vmcnt(" #n ")" ::: "memory")
#define PG8_WAIT_L(n) asm volatile("s_waitcnt lgkmcnt(" #n ")" ::: "memory")
#define PG8_BAR __builtin_amdgcn_s_barrier()
#define PG8_SCHED __builtin_amdgcn_sched_barrier(0)
    Unit cur, nxt; int ui = 0;
    if (!S.next(0, cur)) return;
    f32x4 acc[2][2][4][2];
#pragma unroll
    for (int a = 0; a < 2; ++a)
#pragma unroll
        for (int b = 0; b < 2; ++b)
#pragma unroll
            for (int m = 0; m < 4; ++m)
#pragma unroll
                for (int n = 0; n < 2; ++n) acc[a][b][m][n] = (f32x4){0.f, 0.f, 0.f, 0.f};
    bf16x8 At[4][2], B0[2][2], B1[2][2];
    const char* cA = (const char*)g.A + (size_t)cur.pm * tstepA; const char* cB = (const char*)g.Bt + (size_t)cur.pn * tstep;
    S.a_ready(cur);
    if constexpr (SP2) {
        PG8_STAGE(PG8_SB(0, 0), cB, voffB); PG8_STAGE(PG8_SB(0, 1), cB + hstepB, voffB); PG8_STAGE(PG8_SA(0, 0), cA, voffA); PG8_STAGE(PG8_SA(0, 1), cA + hstepA, voffA);
        if (wr == 1) PG8_BAR;
        PG8_WAIT_V(2); PG8_BAR;
        PG8_STAGE(PG8_SB(1, 0), cB + kstep, voffB); PG8_STAGE(PG8_SA(1, 0), cA + kstepA, voffA); PG8_STAGE(PG8_SB(1, 1), cB + hstepB + kstep, voffB);
        PG8_WAIT_V(6); PG8_BAR;
    } else {
        PG8_STAGE(PG8_SB(0, 0), cB, voffB); PG8_STAGE(PG8_SA(0, 0), cA, voffA); PG8_STAGE(PG8_SB(0, 1), cB + hstepB, voffB); PG8_STAGE(PG8_SA(0, 1), cA + hstepA, voffA);
        if (wr == 1) PG8_BAR;
        PG8_WAIT_V(4); PG8_BAR;
        PG8_STAGE(PG8_SB(1, 0), cB + kstep, voffB); PG8_STAGE(PG8_SA(1, 0), cA + kstepA, voffA); PG8_STAGE(PG8_SB(1, 1), cB + hstepB + kstep, voffB);
        PG8_WAIT_V(6); PG8_BAR;
    }
    for (;;) {
        const bool has_next = S.next(ui + 1, nxt);
        const char* nA = has_next ? (const char*)g.A + (size_t)nxt.pm * tstepA : cA; const char* nB = has_next ? (const char*)g.Bt + (size_t)nxt.pn * tstep : cB;
        for (int t = 0; t < nt; t += 2) {
            const bool last = (t == nt - 2);
            const char* a1 = cA + (size_t)(t + 1) * kstepA;
            const char* a2 = last ? nA : cA + (size_t)(t + 2) * kstepA; const char* b2 = last ? nB : cB + (size_t)(t + 2) * kstep;
            const char* a3 = a2 + kstepA; const char* b3 = b2 + kstep;
            if (last && has_next) S.a_ready(nxt);
            if constexpr (SP2) {
            PG8_LDB(B0, 0, 0); PG8_LDB(B1, 0, 1); PG8_SCHED; PG8_LDA(At, 0, 0); PG8_STAGE(PG8_SA(1, 1), a1 + hstepA, voffA);
            PG8_WAIT_V(8); PG8_WAIT_L(0); PG8_BAR; PG8_MMA(0, 0, At, B0); PG8_MMA(0, 1, At, B1); PG8_BAR; PG8_SCHED;
            PG8_LDA(At, 0, 1); PG8_STAGE(PG8_SB(0, 0), b2, voffB); PG8_STAGE(PG8_SB(0, 1), b2 + hstepB, voffB); PG8_STAGE(PG8_SA(0, 0), a2, voffA);
            PG8_WAIT_V(8); PG8_WAIT_L(0); PG8_BAR; PG8_MMA(1, 0, At, B0); PG8_MMA(1, 1, At, B1); PG8_BAR; PG8_SCHED;
            PG8_LDB(B0, 1, 0); PG8_LDB(B1, 1, 1); PG8_SCHED; PG8_LDA(At, 1, 0); PG8_STAGE(PG8_SA(0, 1), a2 + hstepA, voffA);
            PG8_WAIT_V(8); PG8_WAIT_L(0); PG8_BAR; PG8_MMA(0, 0, At, B0); PG8_MMA(0, 1, At, B1); PG8_BAR; PG8_SCHED;
            PG8_LDA(At, 1, 1); PG8_STAGE(PG8_SB(1, 0), b3, voffB); PG8_STAGE(PG8_SB(1, 1), b3 + hstepB, voffB); PG8_STAGE(PG8_SA(1, 0), a3, voffA);
            PG8_WAIT_V(8); PG8_WAIT_L(0); PG8_BAR; PG8_MMA(1, 0, At, B0); PG8_MMA(1, 1, At, B1); PG8_BAR; PG8_SCHED;
            } else {
            PG8_LDB(B0, 0, 0); PG8_SCHED; PG8_LDA(At, 0, 0); PG8_STAGE(PG8_SA(1, 1), a1 + hstepA, voffA);
            PG8_WAIT_L(8); PG8_BAR; PG8_WAIT_L(0); PG8_MMA(0, 0, At, B0); PG8_BAR; PG8_SCHED;
            PG8_LDB(B1, 0, 1); PG8_STAGE(PG8_SB(0, 0), b2, voffB);
            PG8_BAR; PG8_WAIT_L(0); PG8_MMA(0, 1, At, B1); PG8_BAR;
            PG8_LDA(At, 0, 1); PG8_STAGE(PG8_SA(0, 0), a2, voffA);
            PG8_BAR; PG8_WAIT_L(0); PG8_MMA(1, 0, At, B0); PG8_BAR; PG8_SCHED;
            PG8_STAGE(PG8_SB(0, 1), b2 + hstepB, voffB);
            PG8_WAIT_V(6); PG8_BAR; PG8_MMA(1, 1, At, B1); PG8_BAR;
            PG8_LDB(B0, 1, 0); PG8_SCHED; PG8_LDA(At, 1, 0); PG8_STAGE(PG8_SA(0, 1), a2 + hstepA, voffA);
            PG8_WAIT_L(8); PG8_BAR; PG8_WAIT_L(0); PG8_MMA(0, 0, At, B0); PG8_BAR; PG8_SCHED;
            PG8_LDB(B1, 1, 1); PG8_STAGE(PG8_SB(1, 0), b3, voffB);
            PG8_BAR; PG8_WAIT_L(0); PG8_MMA(0, 1, At, B1); PG8_BAR;
            PG8_LDA(At, 1, 1); PG8_STAGE(PG8_SA(1, 0), a3, voffA);
            PG8_BAR; PG8_WAIT_L(0); PG8_MMA(1, 0, At, B0); PG8_BAR; PG8_SCHED;
            PG8_STAGE(PG8_SB(1, 1), b3 + hstepB, voffB);
            PG8_WAIT_V(6); PG8_BAR; PG8_MMA(1, 1, At, B1); PG8_BAR;
            }
        }
        if constexpr (ALIGN_EPI) { if (wr == 0) PG8_BAR; }
        if constexpr (!Epi::AFTER_DRAIN) { E(acc, cur, wr, wc, fr, fq); S.done(cur); }
        if (!has_next) break;
#pragma unroll
        for (int a = 0; a < 2; ++a)
#pragma unroll
            for (int b = 0; b < 2; ++b)
#pragma unroll
                for (int m = 0; m < 4; ++m)
#pragma unroll
                    for (int n = 0; n < 2; ++n) acc[a][b][m][n] = (f32x4){0.f, 0.f, 0.f, 0.f};
        cur = nxt; cA = nA; cB = nB; ++ui;
        if constexpr (ALIGN_EPI) { if (wr == 1) PG8_BAR; }
    }
    PG8_WAIT_V(0);
    if constexpr (!ALIGN_EPI) { if (wr == 0) PG8_BAR; }
    PG8_BAR;
    if constexpr (Epi::AFTER_DRAIN) { E.fused(acc, cur, wr, wc, fr, fq, lds, wid, lane); S.done(cur); }
#undef PG8_SA
#undef PG8_SB
#undef PG8_STAGE
#undef PG8_LDA
#undef PG8_LDB
#undef PG8_MMA
#undef PG8_WAIT_V
#undef PG8_WAIT_L
#undef PG8_BAR
#undef PG8_SCHED
}
}
#ifndef PG8_SP2
#define PG8_SP2 true
#endif
#ifndef PG8_ALIGN
#define PG8_ALIGN true
#endif

constexpr int NWAVES = 8;
constexpr int BATCH = 8, SEQ = 4096, DM = 1024, DEPTH = 2, M = BATCH * SEQ;
constexpr int HD = 64, SBH = 4, SBW = 256, RH = 8, RW = 512, CW = 256, CK = 31, DFF = 4096, INC = 3328;
constexpr float EPS = 1e-6f;
constexpr float SB_C2 = 0.125f * 1.4426950408889634f;
constexpr size_t MiB = 1u << 20;
constexpr size_t WS_CTL = 0, CTL_ZERO_BYTES = 32768;
constexpr size_t WS_W = 2 * MiB, W_LAYER = 25 * MiB, W_IN = 0, W_OUT = 7 * MiB, W_1 = 9 * MiB, W_2 = 17 * MiB;
constexpr size_t WS_SSQ = 53 * MiB;
constexpr size_t WS_XNG = 56 * MiB;
constexpr size_t WS_RT = 216 * MiB;
constexpr size_t WS_RQT = 232 * MiB;
constexpr size_t WS_RG = 184 * MiB;
constexpr size_t WS_R = 120 * MiB;
constexpr size_t WS_MIX = WS_R, WS_F = WS_R;
constexpr size_t WS_QS = 328 * MiB, WS_KS = 344 * MiB, WS_VS = 360 * MiB;
constexpr size_t WS_RQ = 376 * MiB, WS_RK = 408 * MiB, WS_RV = 440 * MiB;
constexpr size_t WS_HC = 472 * MiB;
constexpr size_t WS_END = 488 * MiB;
static_assert(WS_RQT + 4 * MiB <= WS_QS && WS_F + (size_t)M * DFF * 2 <= WS_HC && WS_HC + (size_t)M * CW * 2 <= WS_END, "d_ws map");
constexpr int CW_BAR = 4096;
constexpr int RING_OFF = 0, RING_BYTES = 131072, LDSCTL_OFF = RING_BYTES, MISC_OFF = LDSCTL_OFF + 320, LDS_BYTES = 147456;

#define GAS __attribute__((address_space(1)))
#define LAS __attribute__((address_space(3)))
typedef unsigned short bf16;
typedef unsigned v4u __attribute__((ext_vector_type(4)));
typedef unsigned v2u __attribute__((ext_vector_type(2)));
typedef float f32x4 __attribute__((ext_vector_type(4)));
#define LDS_WAIT() asm volatile("s_waitcnt lgkmcnt(0)" ::: "memory")
#define VM_WAIT() asm volatile("s_waitcnt vmcnt(0)" ::: "memory")
__device__ __forceinline__ float bf2f(unsigned h) { return __uint_as_float(h << 16); }
__device__ __forceinline__ float bflo(unsigned w) { return __uint_as_float(w << 16); }
__device__ __forceinline__ float bfhi(unsigned w) { return __uint_as_float(w & 0xffff0000u); }
__device__ __forceinline__ unsigned pk2(float lo, float hi) { return pg8::cvt_pk_bf16(lo, hi); }
__device__ __forceinline__ float wave_sum(float v) {
#pragma unroll
    for (int o = 1; o < 64; o <<= 1) v += __shfl_xor(v, o);
    return v;
}

#define XB_TMO      128
#define XB_XCNT(j)  (256  + 64 * (j))
#define XB_XSUB(j)  (1280 + 64 * (j))
#define XB_XGEN(j)  (2304 + 64 * (j))
#define XB_TOP      3328
#define XB_TOPGEN   3392
#define XCD_BAR_WORDS 3456
#define XB_SPIN_CAP (1u << 18)

__device__ __forceinline__ unsigned xb_ld(unsigned* p)              { return __hip_atomic_load(p, __ATOMIC_RELAXED, __HIP_MEMORY_SCOPE_AGENT); }
__device__ __forceinline__ unsigned xb_add(unsigned* p, unsigned v) { return __hip_atomic_fetch_add(p, v, __ATOMIC_RELAXED, __HIP_MEMORY_SCOPE_AGENT); }
__device__ __forceinline__ unsigned xb_xcc_id() { return (unsigned)__builtin_amdgcn_s_getreg((3 << 11) | 20) & 0xFu; }
#define XB_SPIN(cond, bar) do { unsigned _sp = 0; while (cond) { __builtin_amdgcn_s_sleep(1); \
    if ((++_sp & 255u) == 0u) { if (xb_ld(&(bar)[XB_TMO])) break; if (_sp > XB_SPIN_CAP) { atomicAdd(&(bar)[XB_TMO], 1u); break; } } } } while (0)

struct XcdBarrier {
    unsigned* bar; unsigned x;
    volatile LAS unsigned* st;
};

__device__ __forceinline__ XcdBarrier xcd_barrier_post(unsigned* bar, volatile LAS unsigned* st) {
    XcdBarrier b; b.bar = bar; b.x = xb_xcc_id(); b.st = st;
    if (threadIdx.x == 0) (void)xb_add(&bar[XB_XCNT(b.x)], 1u);
    return b;
}
__device__ __forceinline__ void xcd_barrier_complete(unsigned* bar, unsigned x, unsigned& nloc, unsigned& nx) {
    const unsigned G = gridDim.x * gridDim.y * gridDim.z;
    unsigned sum, cnt, mine, sp = 0u;
    for (;;) {
        sum = 0u; cnt = 0u; mine = 0u;
#pragma unroll
        for (unsigned j = 0; j < 16; ++j) { const unsigned c = xb_ld(&bar[XB_XCNT(j)]); sum += c; cnt += (c > 0u) ? 1u : 0u; mine = (j == x) ? c : mine; }
        if (sum == G) break;
        __builtin_amdgcn_s_sleep(1);
        if ((++sp & 255u) == 0u) { if (xb_ld(&bar[XB_TMO])) break; if (sp > XB_SPIN_CAP) { atomicAdd(&bar[XB_TMO], 1u); break; } }
    }
    nloc = mine > 0u ? mine : 1u; nx = cnt > 0u ? cnt : 1u;
}

__device__ __forceinline__ void xcd_barrier(const XcdBarrier& b) {
    asm volatile("s_waitcnt vmcnt(0)" ::: "memory");
    __syncthreads();
    if (threadIdx.x == 0) {
        unsigned* bar = b.bar;
        __builtin_amdgcn_s_waitcnt(0);
        unsigned nloc = b.st[0], nx = b.st[1];
        if (nloc == 0u) { xcd_barrier_complete(bar, b.x, nloc, nx); b.st[0] = nloc; b.st[1] = nx; }
        const unsigned old = xb_add(&bar[XB_XSUB(b.x)], 1u);
        const unsigned gen = old / nloc;
        if (old + 1u == (gen + 1u) * nloc) {
            __builtin_amdgcn_fence(__ATOMIC_RELEASE, "agent");
            asm volatile("s_waitcnt vmcnt(0)" ::: "memory");
            const unsigned og = xb_add(&bar[XB_TOP], 1u);
            const unsigned tg = og / nx;
            if (og + 1u == (tg + 1u) * nx) xb_add(&bar[XB_TOPGEN], 1u);
            else XB_SPIN(xb_ld(&bar[XB_TOPGEN]) == tg, bar);
            __builtin_amdgcn_fence(__ATOMIC_ACQUIRE, "agent");
            xb_add(&bar[XB_XGEN(b.x)], 1u);
            asm volatile("s_waitcnt vmcnt(0)" ::: "memory");
        } else {
            XB_SPIN(xb_ld(&bar[XB_XGEN(b.x)]) == gen, bar);
            __builtin_amdgcn_fence(__ATOMIC_ACQUIRE, "agent");
            asm volatile("s_waitcnt vmcnt(0)" ::: "memory");
        }
    }
    __syncthreads();
}

struct Args {
    const float* x; const float* mix_g; const float* w_in; const float* sbq_g; const float* sbk_g; const float* ret_g; const float* pw_b; const float* dw_w; const float* dw_b;
    const float* ln_g; const float* ln_b; const float* w_out; const float* mlp_g; const float* w_ff1; const float* w_ff2;
    float* out; unsigned char* ws;
    float ret_lg2[8];
    int ph_lo, ph_hi;
};

struct Frame {
    LAS unsigned char* lds;
    int tid, lane, wave, gw;
    unsigned char* ws;
};

template <bool INPROJ> __device__ __forceinline__ void p0_transpose_item(const float* W, const float* gk, int K, int N, bf16* WT, LAS float* scr, int item, int lane) {
    const int nblk = N / 32, kb = item / nblk, nb = item % nblk, k0 = 64 * kb, r0 = 32 * nb, n0 = INPROJ ? pg8::inproj_srccol(r0) : r0;
    float wv[32];
#pragma unroll
    for (int i = 0; i < 32; ++i) wv[i] = W[(size_t)(k0 + 2 * i + (lane >> 5)) * N + n0 + (lane & 31)];
    if (gk) {
#pragma unroll
        for (int i = 0; i < 32; ++i) wv[i] *= gk[k0 + 2 * i + (lane >> 5)]; }
#pragma unroll
    for (int i = 0; i < 32; ++i) scr[(2 * i + (lane >> 5)) * 33 + (lane & 31)] = wv[i];
    LDS_WAIT(); asm volatile("" ::: "memory");
    const int c = lane & 7;
#pragma unroll
    for (int j = 0; j < 4; ++j) { const int n = (lane >> 3) + 8 * j; const LAS float* s = scr + (8 * c) * 33 + n;
        v4u o; o.x = pk2(s[0 * 33], s[1 * 33]); o.y = pk2(s[2 * 33], s[3 * 33]); o.z = pk2(s[4 * 33], s[5 * 33]); o.w = pk2(s[6 * 33], s[7 * 33]);
        *(v4u*)(WT + (size_t)(r0 + n) * K + k0 + 8 * c) = o; }
    LDS_WAIT(); asm volatile("" ::: "memory");
}
__device__ __forceinline__ void xng_row2(const float* x, int m0, int m1, bf16* xb_all, float* ssq, int lane) {
    const f32x4* x0 = (const f32x4*)(x + (size_t)m0 * DM) + lane; const f32x4* x1 = (const f32x4*)(x + (size_t)m1 * DM) + lane;
    f32x4 v[2][4];
#pragma unroll
    for (int j = 0; j < 4; ++j) { v[0][j] = x0[64 * j]; v[1][j] = x1[64 * j]; }
#pragma unroll
    for (int r = 0; r < 2; ++r) { const int m_row = r ? m1 : m0; float s = 0.f;
#pragma unroll
        for (int j = 0; j < 4; ++j) s += (v[r][j][0] * v[r][j][0] + v[r][j][1] * v[r][j][1]) + (v[r][j][2] * v[r][j][2] + v[r][j][3] * v[r][j][3]);
        s = wave_sum(s);
#pragma unroll
        for (int j = 0; j < 4; ++j) { const f32x4 y = v[r][j]; v2u w; w.x = pk2(y[0], y[1]); w.y = pk2(y[2], y[3]); const int c = 4 * lane + 256 * j;
            *(v2u*)(xb_all + ((size_t)((m_row >> 7) * 16 + (c >> 6)) * 8192 + (m_row & 127) * 64 + (c & 63))) = w; }
        if (lane < 16) ssq[(size_t)m_row * 16 + lane] = lane == 0 ? s : 0.f; }
}
__device__ __forceinline__ void convert_weights(Frame& F, const Args& A, int l_lo, int l_hi, int stride_id, int stride) {
    LAS float* scr = (LAS float*)(F.lds + RING_OFF + F.wave * 16384);
    constexpr int I_IN = (DM / 64) * (INC / 32), I_OUT = (DM / 64) * (DM / 32), I_1 = (DM / 64) * (DFF / 32), I_2 = (DFF / 64) * (DM / 32), I_L = I_IN + I_OUT + I_1 + I_2;
    const int first = l_lo * I_L, last = l_hi * I_L;
    for (int it = first + stride_id; it < last; it += stride) {
        const int l = it / I_L; int r = it % I_L; unsigned char* wl = F.ws + WS_W + (size_t)l * W_LAYER;
        if (r < I_IN) { p0_transpose_item<true>(A.w_in + (size_t)l * DM * INC, A.mix_g + l * DM, DM, INC, (bf16*)(wl + W_IN), scr, r, F.lane); continue; } r -= I_IN;
        if (r < I_OUT) { p0_transpose_item<false>(A.w_out + (size_t)l * DM * DM, nullptr, DM, DM, (bf16*)(wl + W_OUT), scr, r, F.lane); continue; } r -= I_OUT;
        if (r < I_1) { p0_transpose_item<false>(A.w_ff1 + (size_t)l * DM * DFF, A.mlp_g + l * DM, DM, DFF, (bf16*)(wl + W_1), scr, r, F.lane); continue; } r -= I_1;
        p0_transpose_item<false>(A.w_ff2 + (size_t)l * DFF * DM, nullptr, DFF, DM, (bf16*)(wl + W_2), scr, r, F.lane);
    }
}
__device__ __forceinline__ void p0_prologue(Frame& F, const Args& A) {
    const int NGW = gridDim.x * NWAVES;
    convert_weights(F, A, 0, 1, F.gw, NGW);
    for (int m = F.gw; m < M / 2; m += NGW) {
        xng_row2(A.x, m, m + M / 2, (bf16*)(F.ws + WS_XNG), (float*)(F.ws + WS_SSQ), F.lane); }
}

__device__ __forceinline__ float sigmoidf_(float x) { return 1.0f / (1.0f + __expf(-x)); }

namespace sba {
typedef short bf16x8 __attribute__((ext_vector_type(8)));
typedef short s16x4 __attribute__((ext_vector_type(4)));
typedef float f32x16 __attribute__((ext_vector_type(16)));
typedef unsigned u32x4 __attribute__((ext_vector_type(4)));
typedef float f32x2_t __attribute__((ext_vector_type(2))); typedef __bf16 bf16x2_t __attribute__((ext_vector_type(2)));
__device__ __forceinline__ unsigned cvtpk(float lo, float hi) { const f32x2_t v = {lo, hi}; const bf16x2_t b = __builtin_convertvector(v, bf16x2_t); return __builtin_bit_cast(unsigned, b); }
__device__ __forceinline__ bf16x8 frag8(const f32x16& x, int s) {
    u32x4 w; w.x = cvtpk(x[8 * s + 0], x[8 * s + 1]); w.y = cvtpk(x[8 * s + 2], x[8 * s + 3]); w.z = cvtpk(x[8 * s + 4], x[8 * s + 5]); w.w = cvtpk(x[8 * s + 6], x[8 * s + 7]);
    return __builtin_bit_cast(bf16x8, w);
}
__device__ __forceinline__ s16x4 vtr(const LAS unsigned char* p) { typedef short v4i16_t __attribute__((ext_vector_type(4))); return __builtin_bit_cast(s16x4, __builtin_amdgcn_ds_read_tr16_b64_v4i16((LAS v4i16_t*)p)); }
constexpr int SB_LDS = 65536; constexpr float SB_EXIT = 160.0f;

template <bool DIAG> __device__ __forceinline__ void sb_subtile(const LAS unsigned char* Kb, const LAS unsigned char* Vb, int hf, int r32, int hi, unsigned vlane, const bf16x8 (&qr)[4],
                                                                bf16x8 U0n, bf16x8 U1n, bf16x8 ONn, f32x16& o0, f32x16& o1, f32x16& carry) {
    f32x16 z;
#pragma unroll
    for (int r = 0; r < 16; ++r) z[r] = 0.f;
#pragma unroll
    for (int d0 = 0; d0 < 4; ++d0) { const bf16x8 kf = *(const LAS bf16x8*)(Kb + (2 * d0 + hi) * 1024 + (32 * hf + r32) * 16); z = __builtin_amdgcn_mfma_f32_32x32x16_bf16(kf, qr[d0], z, 0, 0, 0); }
    f32x16 sp;
#pragma unroll
    for (int r = 0; r < 16; ++r) { const float zz = z[r]; const float e = __builtin_amdgcn_exp2f(-fabsf(zz)); sp[r] = __builtin_fmaf(0.5f, zz + fabsf(zz), __builtin_amdgcn_logf(1.0f + e)); }
    if (DIAG) {
#pragma unroll
        for (int r = 0; r < 16; ++r) { const int keyl = (r & 3) + 8 * (r >> 2) + 4 * hi; if (!(keyl < r32)) sp[r] = 0.f; }
    }
    const bf16x8 x0 = frag8(sp, 0), x1 = frag8(sp, 1);
    f32x16 T = __builtin_amdgcn_mfma_f32_32x32x16_bf16(U0n, x0, carry, 0, 0, 0); T = __builtin_amdgcn_mfma_f32_32x32x16_bf16(U1n, x1, T, 0, 0, 0);
    carry = __builtin_amdgcn_mfma_f32_32x32x16_bf16(ONn, x0, carry, 0, 0, 0); carry = __builtin_amdgcn_mfma_f32_32x32x16_bf16(ONn, x1, carry, 0, 0, 0);
    f32x16 w;
#pragma unroll
    for (int r = 0; r < 16; ++r) w[r] = __builtin_amdgcn_exp2f(z[r] + T[r]);
    if (DIAG) {
#pragma unroll
        for (int r = 0; r < 16; ++r) { const int keyl = (r & 3) + 8 * (r >> 2) + 4 * hi; if (!(keyl < r32)) w[r] = 0.f; }
    }
    const bf16x8 w0 = frag8(w, 0), w1 = frag8(w, 1);
#pragma unroll
    for (int ks = 0; ks < 2; ++ks) { const LAS unsigned char* vp = Vb + vlane + (32 * hf + 16 * ks) * 64;
        const s16x4 a0 = vtr(vp), a1 = vtr(vp + 512), b0 = vtr(vp + 4096), b1 = vtr(vp + 4096 + 512);
        const bf16x8 v0 = (bf16x8){a0[0], a0[1], a0[2], a0[3], a1[0], a1[1], a1[2], a1[3]}, v1 = (bf16x8){b0[0], b0[1], b0[2], b0[3], b1[0], b1[1], b1[2], b1[3]};
        o0 = __builtin_amdgcn_mfma_f32_32x32x16_bf16(ks ? w1 : w0, v0, o0, 0, 0, 0); o1 = __builtin_amdgcn_mfma_f32_32x32x16_bf16(ks ? w1 : w0, v1, o1, 0, 0, 0); }
}
__device__ __forceinline__ void sb_unit(int bh, int qb, const bf16* Qs, const bf16* Ks, const bf16* Vs, bf16* MIX, LAS unsigned char* lds, int tid) {
    const int lane = tid & 63, wave = __builtin_amdgcn_readfirstlane(tid >> 6), r32 = lane & 31, hi = lane >> 5, quad = wave >> 2, tq = tid & 255;
    const int q0 = qb * 256 + quad * 128 + (quad ? 3 - (wave & 3) : (wave & 3)) * 32; const size_t hb = (size_t)bh * SEQ * HD;
    bf16x8 qr[4];
#pragma unroll
    for (int d0 = 0; d0 < 4; ++d0) qr[d0] = *(const bf16x8*)(Qs + hb + (size_t)(q0 + r32) * HD + 16 * d0 + 8 * hi);
    bf16x8 U0, U1, ON;
#pragma unroll
    for (int j = 0; j < 8; ++j) { const int k0 = 8 * (j >> 2) + 4 * hi + (j & 3); U0[j] = (k0 >= r32) ? (short)0xBF80 : (short)0; U1[j] = (16 + k0 >= r32) ? (short)0xBF80 : (short)0; ON[j] = (short)0xBF80; }
    f32x16 o0, o1, carry;
#pragma unroll
    for (int r = 0; r < 16; ++r) { o0[r] = 0.f; o1[r] = 0.f; carry[r] = 0.f; }
    const int NT = 4 * qb + 2 + 2 * quad, NSTEP = 4 * qb + 4;
    LAS unsigned char* ldq = lds + quad * 32768;
    unsigned kdst[2], vdst[2];
#pragma unroll
    for (int i = 0; i < 2; ++i) { const int p = tq + 256 * i, key_i = p >> 3, c_i = p & 7; kdst[i] = (unsigned)(c_i * 1024 + key_i * 16); vdst[i] = (unsigned)(8192 + (c_i >> 2) * 4096 + key_i * 64 + (c_i & 3) * 16); }
    const v4u* kg = (const v4u*)(Ks + hb) + tq; const v4u* vg = (const v4u*)(Vs + hb) + tq;
    {
#pragma unroll
        for (int i = 0; i < 2; ++i) { const v4u kx = kg[(size_t)(NT - 1) * 512 + 256 * i], vx = vg[(size_t)(NT - 1) * 512 + 256 * i]; *(LAS v4u*)(ldq + kdst[i]) = kx; *(LAS v4u*)(ldq + vdst[i]) = vx; } }
    __syncthreads();
    const unsigned vlane = (unsigned)(((lane >> 4) & 1) * 32 + (lane & 3) * 8 + (4 * hi + ((lane & 15) >> 2)) * 64);
    int cur = 0;
    for (int i = 0; i < NSTEP; ++i) {
        const int kt = NT - 1 - i;
        v4u kx[2], vx[2];
        if (kt > 0) {
#pragma unroll
            for (int j = 0; j < 2; ++j) { kx[j] = kg[(size_t)(kt - 1) * 512 + 256 * j]; vx[j] = vg[(size_t)(kt - 1) * 512 + 256 * j]; } }
        const bool wfin = __all(carry[0] <= -SB_EXIT);
        if (kt >= 0 && !wfin) {
            const LAS unsigned char* Kb = ldq + cur * 16384; const LAS unsigned char* Vb = Kb + 8192;
#pragma unroll
            for (int hf = 1; hf >= 0; --hf) {
                const int kbase = kt * 64 + hf * 32;
                if (kbase <= q0) {
                    if (kbase == q0) sb_subtile<true>(Kb, Vb, hf, r32, hi, vlane, qr, U0, U1, ON, o0, o1, carry);
                    else sb_subtile<false>(Kb, Vb, hf, r32, hi, vlane, qr, U0, U1, ON, o0, o1, carry);
                }
            }
        }
        if (kt > 0) {
#pragma unroll
            for (int j = 0; j < 2; ++j) { *(LAS v4u*)(ldq + (cur ^ 1) * 16384 + kdst[j]) = kx[j]; *(LAS v4u*)(ldq + (cur ^ 1) * 16384 + vdst[j]) = vx[j]; } }
        const int wdone = (kt <= 0) || ((kt * 64 <= q0) && __all(carry[0] <= -SB_EXIT));
        if (__syncthreads_and(wdone)) break;
        cur ^= 1;
    }
    const int b = bh >> 2, hh = bh & 3;
#pragma unroll
    for (int r = 0; r < 16; ++r) { const int t = q0 + (r & 3) + 8 * (r >> 2) + 4 * hi; bf16* dst = MIX + (((size_t)((b * SEQ + t) >> 7) * 16 + (hh)) * 8192 + ((b * SEQ + t) & 127) * 64 + (r32));
        dst[0] = (bf16)(cvtpk(o0[r], 0.f) & 0xffffu); dst[32] = (bf16)(cvtpk(o1[r], 0.f) & 0xffffu); }
}
__device__ __forceinline__ void sb_phase(Frame& F) {
    const int G = gridDim.x, bx = blockIdx.x; const int vcu = (G % 8 == 0) ? (bx % 8) * (G / 8) + bx / 8 : bx;
    const bf16 *Qs = (const bf16*)(F.ws + WS_QS), *Ks = (const bf16*)(F.ws + WS_KS), *Vs = (const bf16*)(F.ws + WS_VS); bf16* MIX = (bf16*)(F.ws + WS_MIX);
    for (int u = vcu; u < 256; u += G) { const int bh = u >> 3, s = u & 7;
        sb_unit(bh, s, Qs, Ks, Vs, MIX, F.lds + RING_OFF + 65536, F.tid);
        sb_unit(bh, 15 - s, Qs, Ks, Vs, MIX, F.lds + RING_OFF + 65536, F.tid); }
}
}

__device__ __forceinline__ void conv_phase(Frame& F, const Args& A, int l) {
    const int tid = F.tid, c = tid & 255, th = tid >> 8, lane = F.lane, wave = F.wave;
    LAS float* cbuf = (LAS float*)(F.lds + RING_OFF + 65536);
    const bf16* Hc = (const bf16*)(F.ws + WS_HC); bf16* MIX = (bf16*)(F.ws + WS_MIX);
    const float* dww = A.dw_w + (size_t)l * CK * CW; const float bias = A.dw_b[l * CW + c];
    float w[CK];
#pragma unroll
    for (int j = 0; j < CK; ++j) w[j] = dww[j * CW + c];
    const f32x4 lg = *(const f32x4*)(A.ln_g + l * CW + 4 * lane), lb = *(const f32x4*)(A.ln_b + l * CW + 4 * lane);
    for (int tile = blockIdx.x; tile < M / 64; tile += gridDim.x) {
        const int row0 = tile * 64 + 32 * th, tb = row0 % SEQ, bstart = row0 - tb;
        float acc[32];
#pragma unroll
        for (int o = 0; o < 32; ++o) acc[o] = bias;
        unsigned short hv[62];
        const bf16* hp = Hc + ((ptrdiff_t)row0 - (CK - 1)) * CW + c;
#pragma unroll
        for (int q = 0; q < 62; ++q) hv[q] = hp[q * CW];
        asm volatile("" ::: "memory");
#pragma unroll
        for (int q = 0; q < 62; ++q) {
            const bool ok = (row0 - (CK - 1) + q) >= bstart; const float x = ok ? bf2f(hv[q]) : 0.f;
#pragma unroll
            for (int o = (q > 30 ? q - 30 : 0); o <= (q < 31 ? q : 31); ++o) acc[o] += w[q - o] * x;
        }
#pragma unroll
        for (int o = 0; o < 32; ++o) cbuf[(32 * th + o) * CW + c] = acc[o];
        __syncthreads();
#pragma unroll 2
        for (int k = 0; k < 8; ++k) { const int tok = wave * 8 + k; const f32x4 v = *(const LAS f32x4*)(cbuf + tok * CW + 4 * lane);
            const float mean = wave_sum((v[0] + v[1]) + (v[2] + v[3])) * (1.0f / 256.0f); const f32x4 d = v - mean;
            const float var = wave_sum((d[0] * d[0] + d[1] * d[1]) + (d[2] * d[2] + d[3] * d[3])) * (1.0f / 256.0f); const float r = __builtin_amdgcn_rsqf(var + EPS);
            const f32x4 y = d * r * lg + lb; v2u o; o.x = pk2(y[0] * sigmoidf_(y[0]), y[1] * sigmoidf_(y[1])); o.y = pk2(y[2] * sigmoidf_(y[2]), y[3] * sigmoidf_(y[3]));
            *(v2u*)(MIX + (((size_t)((tile * 64 + tok) >> 7) * 16 + (12 + (lane >> 4))) * 8192 + ((tile * 64 + tok) & 127) * 64 + ((4 * lane) & 63))) = o; }
        __syncthreads();
    }
}

namespace ret2 {
constexpr int RET_CPG = 4, RET_NG = 64 / RET_CPG, RET_WAVES = 4;
using sba::bf16x8; using sba::s16x4; using sba::f32x16; using sba::frag8; using sba::vtr; using sba::cvtpk;
__device__ __forceinline__ bf16x8 tr2(const LAS unsigned char* p) { const s16x4 a = vtr(p), b = vtr(p + 512); return (bf16x8){a[0], a[1], a[2], a[3], b[0], b[1], b[2], b[3]}; }
#define RET_MFMA(a, b, c) __builtin_amdgcn_mfma_f32_32x32x16_bf16(a, b, c, 0, 0, 0)
__device__ __forceinline__ void stage_tiles(const bf16* Kt, const bf16* Vt, LAS unsigned char* Kimg, LAS unsigned char* Vimg, int lane) {
    v4u kx[8], vx[8];
#pragma unroll
    for (int i = 0; i < 8; ++i) { kx[i] = ((const v4u*)Kt)[lane + 64 * i]; vx[i] = ((const v4u*)Vt)[lane + 64 * i]; }
    asm volatile("" ::: "memory");
#pragma unroll
    for (int i = 0; i < 8; ++i) { const int p = lane + 64 * i, key = p >> 3, c = p & 7; const unsigned dst = (unsigned)((c >> 2) * 4096 + key * 64 + (c & 3) * 16);
        *(LAS v4u*)(Kimg + dst) = kx[i]; *(LAS v4u*)(Vimg + dst) = vx[i]; }
    asm volatile("s_waitcnt lgkmcnt(0)" ::: "memory");
}
#define RET_KV() do { _Pragma("unroll") for (int ks = 0; ks < 4; ++ks) { \
            const bf16x8 k0_ = tr2(Kimg + ks * 1024 + vlane), k1_ = tr2(Kimg + 4096 + ks * 1024 + vlane), v0_ = tr2(Vimg + ks * 1024 + vlane), v1_ = tr2(Vimg + 4096 + ks * 1024 + vlane); \
            S00 = RET_MFMA(k0_, v0_, S00); S01 = RET_MFMA(k0_, v1_, S01); S10 = RET_MFMA(k1_, v0_, S10); S11 = RET_MFMA(k1_, v1_, S11); } \
        _Pragma("unroll") for (int r = 0; r < 16; ++r) { S00[r] *= g64; S01[r] *= g64; S10[r] *= g64; S11[r] *= g64; } } while (0)
__device__ __forceinline__ void ret_m1(int bh, int g, const Args& A, unsigned char* ws, LAS unsigned char* wlds, int lane) {
    const int hi = lane >> 5, hh = bh & 7; const float lg2 = A.ret_lg2[hh], g64 = __builtin_amdgcn_exp2f(64.f * lg2);
    const size_t hb = (size_t)bh * SEQ * HD; const bf16 *Rk = (const bf16*)(ws + WS_RK) + hb, *Rv = (const bf16*)(ws + WS_RV) + hb;
    LAS unsigned char* Kimg = wlds; LAS unsigned char* Vimg = wlds + 8192;
    const unsigned vlane = (unsigned)(((lane >> 4) & 1) * 32 + (lane & 3) * 8 + (4 * hi + ((lane & 15) >> 2)) * 64);
    f32x16 S00, S01, S10, S11;
#pragma unroll
    for (int r = 0; r < 16; ++r) { S00[r] = 0.f; S01[r] = 0.f; S10[r] = 0.f; S11[r] = 0.f; }
    for (int s = 0; s < RET_CPG; ++s) { const int n = RET_CPG * g + s;
        stage_tiles(Rk + (size_t)n * 64 * HD, Rv + (size_t)n * 64 * HD, Kimg, Vimg, lane);
        RET_KV(); }
    float* T = (float*)(ws + WS_RT) + (size_t)(bh * RET_NG + g) * 4096 + lane;
#pragma unroll
    for (int r = 0; r < 16; ++r) { T[(0 * 16 + r) * 64] = S00[r]; T[(1 * 16 + r) * 64] = S01[r]; T[(2 * 16 + r) * 64] = S10[r]; T[(3 * 16 + r) * 64] = S11[r]; }
    asm volatile("s_waitcnt vmcnt(0)" ::: "memory");
}
__device__ __forceinline__ void ret_m3(int bh, int g, int part, const Args& A, int l, unsigned char* ws, LAS unsigned char* wlds, int lane) {
    const int r32 = lane & 31, hi = lane >> 5, b = bh >> 3, hh = bh & 7; const float lg2 = A.ret_lg2[hh], g64 = __builtin_amdgcn_exp2f(64.f * lg2), g512 = __builtin_amdgcn_exp2f((float)(64 * RET_CPG) * lg2);
    const size_t hb = (size_t)bh * SEQ * HD;
    const bf16 *Rq = (const bf16*)(ws + WS_RQ) + hb, *Rk = (const bf16*)(ws + WS_RK) + hb, *Rv = (const bf16*)(ws + WS_RV) + hb, *Rg = (const bf16*)(ws + WS_RG); bf16* MIX = (bf16*)(ws + WS_MIX);
    LAS unsigned char* Kimg = wlds; LAS unsigned char* Vimg = wlds + 8192;
    const unsigned vlane = (unsigned)(((lane >> 4) & 1) * 32 + (lane & 3) * 8 + (4 * hi + ((lane & 15) >> 2)) * 64);
    f32x16 S00, S01, S10, S11;
#pragma unroll
    for (int r = 0; r < 16; ++r) { S00[r] = 0.f; S01[r] = 0.f; S10[r] = 0.f; S11[r] = 0.f; }
    {
        const int q = g >> 2, nsteps = q + (g & 3); const float g1024 = __builtin_amdgcn_exp2f(1024.f * lg2);
        const float* Qb = (const float*)(ws + WS_RQT) + (size_t)(bh * 4) * 4096 + lane; const float* Tb = (const float*)(ws + WS_RT) + (size_t)(bh * RET_NG + 4 * q) * 4096 + lane;
        if (nsteps > 0) {
            const float* p0 = q > 0 ? Qb : Tb; f32x16 t0, t1, t2, t3;
#pragma unroll
            for (int r = 0; r < 16; ++r) { t0[r] = p0[(0 * 16 + r) * 64]; t1[r] = p0[(1 * 16 + r) * 64]; t2[r] = p0[(2 * 16 + r) * 64]; t3[r] = p0[(3 * 16 + r) * 64]; }
            for (int k = 0; k < nsteps; ++k) { f32x16 n0 = t0, n1 = t1, n2 = t2, n3 = t3; const float fac = k < q ? g1024 : g512;
                if (k + 1 < nsteps) { const float* pn = (k + 1 < q) ? Qb + (size_t)(k + 1) * 4096 : Tb + (size_t)(k + 1 - q) * 4096;
#pragma unroll
                    for (int r = 0; r < 16; ++r) { n0[r] = pn[(0 * 16 + r) * 64]; n1[r] = pn[(1 * 16 + r) * 64]; n2[r] = pn[(2 * 16 + r) * 64]; n3[r] = pn[(3 * 16 + r) * 64]; } }
#pragma unroll
                for (int r = 0; r < 16; ++r) { S00[r] = S00[r] * fac + t0[r]; S01[r] = S01[r] * fac + t1[r]; S10[r] = S10[r] * fac + t2[r]; S11[r] = S11[r] * fac + t3[r]; }
                t0 = n0; t1 = n1; t2 = n2; t3 = n3; } } }
    if (part == 1) { for (int s = 0; s < RET_CPG / 2; ++s) { const int n = RET_CPG * g + s;
            stage_tiles(Rk + (size_t)n * 64 * HD, Rv + (size_t)n * 64 * HD, Kimg, Vimg, lane); RET_KV(); } }
    const float* gnp = A.ret_g + l * RW + hh * HD + 4 * hi;
    for (int s = (part == 1) ? RET_CPG / 2 : 0; s < ((part == 0) ? RET_CPG / 2 : RET_CPG); ++s) {
        const int n = RET_CPG * g + s, t0 = 64 * n;
        stage_tiles(Rk + (size_t)n * 64 * HD, Rv + (size_t)n * 64 * HD, Kimg, Vimg, lane);
#pragma unroll
        for (int ih = 0; ih < 2; ++ih) {
            const bf16* qrow = Rq + (size_t)(t0 + 32 * ih + r32) * HD; const size_t orow = (size_t)b * SEQ + t0 + 32 * ih + r32;
            v2u gate[2][4];
#pragma unroll
            for (int eh = 0; eh < 2; ++eh)
#pragma unroll
                for (int q = 0; q < 4; ++q) gate[eh][q] = *(const v2u*)(Rg + orow * RW + hh * HD + 32 * eh + 8 * q + 4 * hi);
            bf16x8 qf[4];
#pragma unroll
            for (int d0 = 0; d0 < 4; ++d0) qf[d0] = *(const bf16x8*)(qrow + 16 * d0 + 8 * hi);
            f32x16 p, z0, z1;
#pragma unroll
            for (int r = 0; r < 16; ++r) { p[r] = 0.f; z0[r] = 0.f; z1[r] = 0.f; }
#pragma unroll
            for (int d0 = 0; d0 < 4; ++d0) { const bf16x8 kf = *(const LAS bf16x8*)(Kimg + (d0 >> 1) * 4096 + r32 * 64 + (d0 & 1) * 32 + hi * 16); p = RET_MFMA(kf, qf[d0], p); }
            if (ih == 0) {
#pragma unroll
                for (int r = 0; r < 16; ++r) { const int j = (r & 3) + 8 * (r >> 2) + 4 * hi; if (j > r32) p[r] = 0.f; }
            }
#pragma unroll
            for (int ks = 0; ks < 2; ++ks) { const bf16x8 pf = frag8(p, ks), v0 = tr2(Vimg + ks * 1024 + vlane), v1 = tr2(Vimg + 4096 + ks * 1024 + vlane); z0 = RET_MFMA(v0, pf, z0); z1 = RET_MFMA(v1, pf, z1); }
            if (ih == 1) {
#pragma unroll
                for (int r = 0; r < 16; ++r) p[r] = 0.f;
#pragma unroll
                for (int d0 = 0; d0 < 4; ++d0) { const bf16x8 kf = *(const LAS bf16x8*)(Kimg + (d0 >> 1) * 4096 + (32 + r32) * 64 + (d0 & 1) * 32 + hi * 16); p = RET_MFMA(kf, qf[d0], p); }
#pragma unroll
                for (int r = 0; r < 16; ++r) { const int j = (r & 3) + 8 * (r >> 2) + 4 * hi; if (j > r32) p[r] = 0.f; }
#pragma unroll
                for (int ks = 0; ks < 2; ++ks) { const bf16x8 pf = frag8(p, ks), v0 = tr2(Vimg + (2 + ks) * 1024 + vlane), v1 = tr2(Vimg + 4096 + (2 + ks) * 1024 + vlane); z0 = RET_MFMA(v0, pf, z0); z1 = RET_MFMA(v1, pf, z1); }
            }
#pragma unroll
            for (int ks = 0; ks < 4; ++ks) { const v2u a = *(const v2u*)(qrow + 16 * ks + 4 * hi), c = *(const v2u*)(qrow + 16 * ks + 8 + 4 * hi);
                const bf16x8 qa = __builtin_bit_cast(bf16x8, (v4u){a.x, a.y, c.x, c.y});
                const bf16x8 s0 = (ks < 2) ? frag8(S00, ks & 1) : frag8(S10, ks & 1), s1 = (ks < 2) ? frag8(S01, ks & 1) : frag8(S11, ks & 1);
                z0 = RET_MFMA(s0, qa, z0); z1 = RET_MFMA(s1, qa, z1); }
            const float gi = __builtin_amdgcn_exp2f((float)(32 * ih + r32) * lg2); float ss = 0.f;
#pragma unroll
            for (int r = 0; r < 16; ++r) { z0[r] *= gi; z1[r] *= gi; ss += z0[r] * z0[r] + z1[r] * z1[r]; }
            ss += __shfl_xor(ss, 32);
            const float rn = __builtin_amdgcn_rsqf(ss * (1.0f / 64.0f) + EPS);
            bf16* dst = MIX + (((size_t)(((int)orow) >> 7) * 16 + (4 + hh)) * 8192 + (((int)orow) & 127) * 64 + (4 * hi));
#pragma unroll
            for (int eh = 0; eh < 2; ++eh)
#pragma unroll
                for (int q = 0; q < 4; ++q) { const v2u gt = gate[eh][q]; const f32x4 gq = *(const f32x4*)(gnp + 32 * eh + 8 * q);
                    const float y0 = (eh ? z1 : z0)[4 * q + 0] * rn * gq[0] * bflo(gt.x), y1 = (eh ? z1 : z0)[4 * q + 1] * rn * gq[1] * bfhi(gt.x);
                    const float y2 = (eh ? z1 : z0)[4 * q + 2] * rn * gq[2] * bflo(gt.y), y3 = (eh ? z1 : z0)[4 * q + 3] * rn * gq[3] * bfhi(gt.y);
                    v2u o; o.x = cvtpk(y0, y1); o.y = cvtpk(y2, y3); *(v2u*)(dst + 32 * eh + 8 * q) = o; }
        }
        RET_KV();
    }
}
#undef RET_KV
#undef RET_MFMA
__device__ __forceinline__ void ret_pass(Frame& F, const Args& A, int l, bool m3) {
#ifndef RET_M3_SPLIT
#define RET_M3_SPLIT 1
#endif
    if (m3 && RET_M3_SPLIT) {
        for (int it = blockIdx.x * NWAVES + F.wave; it < BATCH * RH * RET_NG * 2; it += gridDim.x * NWAVES)
            ret_m3((it >> 1) / RET_NG, (it >> 1) % RET_NG, (it & 1) ^ ((F.wave >> 2) & 1), A, l, F.ws, F.lds + RING_OFF + F.wave * 16384, F.lane);
        return; }
    if (m3) { if (F.wave >= RET_WAVES) return;
        for (int it = blockIdx.x * RET_WAVES + F.wave; it < BATCH * RH * RET_NG; it += gridDim.x * RET_WAVES) ret_m3(it / RET_NG, it % RET_NG, 2, A, l, F.ws, F.lds + RING_OFF + F.wave * 16384, F.lane);
        return; }
    if (F.wave >= RET_WAVES) return;
    for (int it = blockIdx.x * RET_WAVES + F.wave; it < BATCH * RH * RET_NG; it += gridDim.x * RET_WAVES)
        ret_m1(it / RET_NG, it % RET_NG, A, F.ws, F.lds + RING_OFF + F.wave * 16384, F.lane);
}
__device__ __forceinline__ void quarter_combine(Frame& F, const Args& A) {
    if (F.wave >= RET_WAVES) return;
    for (int c = blockIdx.x; c < BATCH * RH * 4; c += gridDim.x) { const int bh = c >> 2; const float g256 = __builtin_amdgcn_exp2f((float)(64 * RET_CPG) * A.ret_lg2[bh & 7]);
        const float* T = (const float*)(F.ws + WS_RT) + (size_t)(c * 4) * 4096 + (F.wave * 16) * 64 + F.lane; float* Q = (float*)(F.ws + WS_RQT) + (size_t)c * 4096 + (F.wave * 16) * 64 + F.lane;
        float acc[16];
#pragma unroll
        for (int r = 0; r < 16; ++r) acc[r] = T[r * 64];
#pragma unroll
        for (int i = 1; i < 4; ++i) {
#pragma unroll
            for (int r = 0; r < 16; ++r) acc[r] = acc[r] * g256 + T[(size_t)i * 4096 + r * 64]; }
#pragma unroll
        for (int r = 0; r < 16; ++r) __hip_atomic_store(Q + r * 64, acc[r], __ATOMIC_RELAXED, __HIP_MEMORY_SCOPE_AGENT);
    }
    asm volatile("s_waitcnt vmcnt(0)" ::: "memory");
}
__device__ __forceinline__ void quarter_publish(unsigned* flags, int tid) {
    __syncthreads();
    if (tid == 0) __hip_atomic_store(flags + blockIdx.x, 1u, __ATOMIC_RELAXED, __HIP_MEMORY_SCOPE_AGENT);
}
__device__ __forceinline__ void quarter_wait(unsigned* flags, int tid) {
    const int c = (int)blockIdx.x, q = c & 3;
    if (tid == 0 && q > 0) {
        for (int k = 0; k < q; ++k) while (__hip_atomic_load(flags + (c & ~3) + k, __ATOMIC_RELAXED, __HIP_MEMORY_SCOPE_AGENT) == 0u) __builtin_amdgcn_s_sleep(2);
        __builtin_amdgcn_fence(__ATOMIC_ACQUIRE, "agent");
        asm volatile("s_waitcnt vmcnt(0)" ::: "memory");
    }
    __syncthreads();
}
}

constexpr int PH_PER_LAYER = 5, N_PHASES = 1 + DEPTH * PH_PER_LAYER;
constexpr int CW_QFLAG = 1024;
__global__ void __launch_bounds__(NWAVES * 64, 2) mk_fwd(Args args) {
    extern __shared__ __attribute__((aligned(16))) unsigned char lds[];
    Frame F;
    F.lds = (LAS unsigned char*)lds; F.tid = threadIdx.x; F.lane = F.tid & 63; F.wave = __builtin_amdgcn_readfirstlane(F.tid >> 6); F.gw = blockIdx.x * NWAVES + F.wave; F.ws = args.ws;
#if MK_ONE_LAUNCH
    cg::grid_group grid = cg::this_grid();
    for (int u = threadIdx.x; u < (LDS_BYTES - LDSCTL_OFF) / 4; u += NWAVES * 64) ((LAS unsigned*)(F.lds + LDSCTL_OFF))[u] = 0u;
    __syncthreads();
    XcdBarrier bar = xcd_barrier_post((unsigned*)(args.ws + WS_CTL) + CW_BAR, (volatile LAS unsigned*)(F.lds + MISC_OFF) + 8);
#endif
    for (int ph = args.ph_lo; ph < args.ph_hi; ++ph) {
        { int t_ = threadIdx.x; asm volatile("" : "+v"(t_)); F.tid = t_; F.lane = t_ & 63; F.wave = __builtin_amdgcn_readfirstlane(t_ >> 6); F.gw = blockIdx.x * NWAVES + F.wave; }
#ifdef PROBE_KIND
#ifndef PROBE_REPS
#define PROBE_REPS 1
#endif
        const int pp = ph > PROBE_KIND + PROBE_REPS ? ph - PROBE_REPS : (ph > PROBE_KIND ? PROBE_KIND : ph);
#else
        const int pp = ph;
#endif
        const int l = pp == 0 ? 0 : (pp - 1) / PH_PER_LAYER, kind = pp == 0 ? 0 : ((pp - 1) % PH_PER_LAYER) + 1;
        unsigned char* wl = F.ws + WS_W + (size_t)l * W_LAYER;
        if (kind == 0) p0_prologue(F, args);
        else if (kind == 1) {
            pg8::Gemm g{(const pg8::bf16_t*)(F.ws + WS_XNG), (const pg8::bf16_t*)(wl + W_IN), M, INC, DM, 1}; pg8::StaticOrder S; S.init(M, INC, gridDim.x, (int)blockIdx.x);
            pg8::fill_rs(F.lds, S, (const float*)(F.ws + WS_SSQ));
            pg8::EpiInProj E{F.lds, F.ws, args.sbq_g + l * HD, args.sbk_g + l * HD, args.pw_b + l * 2 * CW, WS_QS, WS_KS, WS_VS, WS_RQ, WS_RK, WS_RV, WS_RG, WS_HC, 0, SB_C2, EPS};
            pg8::gemm_phase<pg8::EpiInProj, pg8::StaticOrder, PG8_ALIGN, PG8_SP2>(F.lds + RING_OFF, g, S, E);
            if (l == 0 && blockIdx.x >= 128) convert_weights(F, args, 1, DEPTH, ((int)blockIdx.x - 128) * NWAVES + F.wave, ((int)gridDim.x - 128) * NWAVES);
        }
        else if (kind == 2) { unsigned* qf = (unsigned*)(F.ws + WS_CTL) + CW_QFLAG + l * 256;
            ret2::ret_pass(F, args, l, false); conv_phase(F, args, l); ret2::quarter_combine(F, args); ret2::quarter_publish(qf, F.tid); sba::sb_phase(F); ret2::quarter_wait(qf, F.tid); ret2::ret_pass(F, args, l, true); }
        else if (kind == 4) {
            pg8::Gemm g{(const pg8::bf16_t*)(F.ws + WS_XNG), (const pg8::bf16_t*)(wl + W_1), M, DFF, DM, 1}; pg8::StaticOrder S; S.init(M, DFF, gridDim.x, (int)blockIdx.x);
            pg8::fill_rs(F.lds, S, (const float*)(F.ws + WS_SSQ));
            pg8::EpiScaleBf16 E{(pg8::bf16_t*)(F.ws + WS_F), DFF, F.lds, 1};
            pg8::gemm_phase<pg8::EpiScaleBf16, pg8::StaticOrder, PG8_ALIGN, PG8_SP2>(F.lds + RING_OFF, g, S, E);
        }
        else {
            const bool ff = kind == 5; const bool last = ff && (l + 1 == DEPTH);
            pg8::Gemm g{(const pg8::bf16_t*)(F.ws + (ff ? WS_F : WS_MIX)), (const pg8::bf16_t*)(wl + (ff ? W_2 : W_OUT)), M, DM, ff ? DFF : DM, 1}; pg8::StaticOrder S; S.init(M, DM, gridDim.x, (int)blockIdx.x);
            pg8::EpiResid E{(pg8::bf16_t*)(F.ws + WS_XNG), last ? args.out : nullptr, (float*)(F.ws + WS_SSQ)};
            pg8::gemm_phase<pg8::EpiResid, pg8::StaticOrder, PG8_ALIGN, PG8_SP2>(F.lds + RING_OFF, g, S, E);
        }
#if MK_ONE_LAUNCH
        if (ph + 1 < args.ph_hi) { if (args.ph_hi > 4096) grid.sync(); xcd_barrier(bar); }
#endif
    }
}

extern "C" void kernel_launch(void* const* d_in, const int* in_sizes, int n_in, void* d_out, int out_size, void* d_ws, size_t ws_size, hipStream_t stream) {
    static int grid = 0;
    if (grid == 0) {
        if (n_in != 15 || in_sizes[0] != M * DM || out_size != M * DM || ws_size < WS_END) { fprintf(stderr, "kernel_launch: unexpected shapes (n_in %d, in0 %d, out %d, ws %zu); nothing launched\n", n_in, n_in > 0 ? in_sizes[0] : -1, out_size, ws_size); grid = -1; return; }
        int dev = 0, cus = 0, per_cu = 0;
        if (hipGetDevice(&dev) != hipSuccess || hipDeviceGetAttribute(&cus, hipDeviceAttributeMultiprocessorCount, dev) != hipSuccess) { grid = -1; return; }
        if (hipFuncSetAttribute((const void*)mk_fwd, hipFuncAttributeMaxDynamicSharedMemorySize, LDS_BYTES) != hipSuccess) { fprintf(stderr, "kernel_launch: hipFuncSetAttribute failed\n"); grid = -1; return; }
        if (hipOccupancyMaxActiveBlocksPerMultiprocessor(&per_cu, (const void*)mk_fwd, NWAVES * 64, LDS_BYTES) != hipSuccess || per_cu < 1) { fprintf(stderr, "kernel_launch: occupancy query says %d blocks per CU\n", per_cu); per_cu = 1; }
        (void)hipGetLastError();
        if (cus < 256) { fprintf(stderr, "kernel_launch: built for a 256-CU device (unit lists and LDS tables are sized for 256 workgroups); found %d CUs; nothing launched\n", cus); grid = -1; return; }
        grid = 256;
    }
    if (grid < 0) return;
    (void)hipMemsetAsync((char*)d_ws + WS_CTL, 0, CTL_ZERO_BYTES, stream);
    Args a{};
    a.x = (const float*)d_in[0]; a.mix_g = (const float*)d_in[1]; a.w_in = (const float*)d_in[2]; a.sbq_g = (const float*)d_in[3]; a.sbk_g = (const float*)d_in[4]; a.ret_g = (const float*)d_in[5];
    a.pw_b = (const float*)d_in[6]; a.dw_w = (const float*)d_in[7]; a.dw_b = (const float*)d_in[8]; a.ln_g = (const float*)d_in[9]; a.ln_b = (const float*)d_in[10]; a.w_out = (const float*)d_in[11];
    a.mlp_g = (const float*)d_in[12]; a.w_ff1 = (const float*)d_in[13]; a.w_ff2 = (const float*)d_in[14];
    a.out = (float*)d_out; a.ws = (unsigned char*)d_ws;
    for (int h = 0; h < 8; ++h) a.ret_lg2[h] = (float)log2(1.0 - exp2(-5.0 - (double)h));
#if MK_ONE_LAUNCH
#ifdef PROBE_KIND
    a.ph_lo = 0; a.ph_hi = N_PHASES + PROBE_REPS;
#else
    a.ph_lo = 0; a.ph_hi = N_PHASES;
#endif
    void* kargs[] = {&a};
    hipError_t e = hipLaunchCooperativeKernel((const void*)mk_fwd, dim3(grid), dim3(NWAVES * 64), kargs, LDS_BYTES, stream);
    if (e != hipSuccess) fprintf(stderr, "kernel_launch: cooperative launch failed: %s (grid %d)\n", hipGetErrorString(e), grid);
#else
    for (int p = 0; p < N_PHASES; ++p) { a.ph_lo = p; a.ph_hi = p + 1; hipLaunchKernelGGL(mk_fwd, dim3(grid), dim3(NWAVES * 64), LDS_BYTES, stream, a); }
#endif
}
```

```cpp
#include <hip/hip_runtime.h>
#include <hip/hip_cooperative_groups.h>
#include <cstdio>
#include <cstdint>
#include <cmath>
namespace cg = cooperative_groups;

#ifndef MK_ONE_LAUNCH
#define MK_ONE_LAUNCH 1
#endif
namespace pg8 {
#define PG8_LAS __attribute__((address_space(3)))
typedef unsigned short bf16_t;
typedef short bf16x8 __attribute__((ext_vector_type(8)));
typedef float f32x4 __attribute__((ext_vector_type(4)));
typedef unsigned u32x4 __attribute__((ext_vector_type(4)));
constexpr int BM = 256, BK = 64, HALF = 128, HTB = HALF * BK * 2  , STAGE_BYTES = 8 * HTB, NXCD = 8, WGM = 8;

__host__ __device__ __forceinline__ int lds_byte(int r, int c) { const int st = (r >> 4) * 2 + (c >> 5), rr = r & 15, cc = c & 31, ob = rr * 64 + cc * 2; return st * 1024 + (ob ^ (((ob >> 9) & 1) << 5)); }
__host__ __device__ __forceinline__ void stage_rc(int b, int& R, int& C) { const int st = b / 1024, sb = b % 1024, swz = sb ^ (((sb >> 9) & 1) << 5); R = (st >> 1) * 16 + swz / 64; C = (st & 1) * 32 + (swz % 64) / 2; }
__host__ __device__ __forceinline__ int perm32(int rho) { const int n = rho >> 4, i = rho & 15; return 8 * (i >> 2) + 4 * n + (i & 3); }

struct Unit { int pm, pn, idx; };
struct Gemm { const bf16_t* A; const bf16_t* Bt; int M, N, K; int a_blocked; };

struct StaticOrder {
    int nM, nN, nwg, G, c;
    __host__ __device__ void init(int M, int N, int G_, int c_) { nM = M / BM; nN = N / BM; nwg = nM * nN; G = G_; c = c_; }
    __host__ __device__ bool next(int i, Unit& u) const {
        const long L = (long)i * G + c; if (L >= nwg) return false;
        int wgid = (int)L; { const int q = nwg / NXCD, r = nwg % NXCD, xcd = wgid % NXCD, off = wgid / NXCD; wgid = (xcd < r ? xcd * (q + 1) : r * (q + 1) + (xcd - r) * q) + off; }
        const int nig = WGM * nN, gid = wgid / nig, fm = gid * WGM, gsz = (nM - fm) < WGM ? (nM - fm) : WGM;
        u.pm = fm + ((wgid % nig) % gsz); u.pn = (wgid % nig) / gsz; u.idx = i; return true;
    }
    __device__ __forceinline__ void a_ready(const Unit&) const {}
    __device__ __forceinline__ void done(const Unit&) const {}
};

typedef float f32x2c_t __attribute__((ext_vector_type(2))); typedef __bf16 bf16x2c_t __attribute__((ext_vector_type(2)));
__device__ __forceinline__ unsigned cvt_pk_bf16(float lo, float hi) { const f32x2c_t v = {lo, hi}; const bf16x2c_t b = __builtin_convertvector(v, bf16x2c_t); return __builtin_bit_cast(unsigned, b); }
typedef float f32x2 __attribute__((ext_vector_type(2)));
constexpr float RMS_EPS = 1e-6f;
constexpr int RS_OFF = 131072 + 1024;
template <class Sched> __device__ __forceinline__ void fill_rs(PG8_LAS unsigned char* lds0, const Sched& S, const float* ssq) {
    PG8_LAS float* rsl = (PG8_LAS float*)(lds0 + RS_OFF); Unit u;
#pragma unroll 1
    for (int i = 0; i < 8 && S.next(i, u); ++i) { int t = threadIdx.x; asm volatile("" : "+v"(t));
        if (t < 256) { const f32x4* p = (const f32x4*)(ssq + (size_t)(u.pm * BM + t) * 16); const f32x4 a = p[0], b = p[1], c = p[2], d = p[3];
            const float s = ((a[0] + a[1]) + (a[2] + a[3])) + ((b[0] + b[1]) + (b[2] + b[3])) + ((c[0] + c[1]) + (c[2] + c[3])) + ((d[0] + d[1]) + (d[2] + d[3]));
            rsl[i * 256 + t] = __builtin_amdgcn_rsqf(s * (1.0f / 1024.0f) + RMS_EPS); } }
    __syncthreads();
}
#define PG8_ROW_RS(lds0_, u_, row_) (((const PG8_LAS float*)((lds0_) + RS_OFF))[(u_).idx * 256 + ((row_) & 255)])
__device__ __forceinline__ u32x4 pair_swap(u32x4 x) { u32x4 y;
    y.x = (unsigned)__builtin_amdgcn_mov_dpp((int)x.x, 0xB1, 0xF, 0xF, true); y.y = (unsigned)__builtin_amdgcn_mov_dpp((int)x.y, 0xB1, 0xF, 0xF, true);
    y.z = (unsigned)__builtin_amdgcn_mov_dpp((int)x.z, 0xB1, 0xF, 0xF, true); y.w = (unsigned)__builtin_amdgcn_mov_dpp((int)x.w, 0xB1, 0xF, 0xF, true); return y; }
#define PG8_FULL_LINE(w0_, w1_, odd_, sa_, sb_) do { const u32x4 snd_ = (odd_) ? (w0_) : (w1_); const u32x4 rcv_ = pair_swap(snd_); sa_ = (odd_) ? rcv_ : (w0_); sb_ = (odd_) ? (w1_) : rcv_; } while (0)
__device__ __forceinline__ __amdgpu_buffer_rsrc_t wt_rsrc(void* base, unsigned bytes) { return __builtin_amdgcn_make_buffer_rsrc(base, 0, bytes, 0x00020000); }
__device__ __forceinline__ void st16_wt(__amdgpu_buffer_rsrc_t r, unsigned byteoff, u32x4 v) { __builtin_amdgcn_raw_buffer_store_b128(v, r, byteoff, 0,   16); }
struct EpiScaleBf16 {
    static constexpr bool PERM = true, AFTER_DRAIN = false;
    bf16_t* O; int ldc; PG8_LAS unsigned char* lds0; int ACT;
    __device__ __forceinline__ void operator()(const f32x4 (&acc)[2][2][4][2], const Unit& u, int wr, int wc, int fr, int fq) const {
        const int row0 = u.pm * BM + wr * 64 + fr; const int odd = fr & 1;
        const __amdgpu_buffer_rsrc_t orr = wt_rsrc(O, (unsigned)(32768u * (unsigned)ldc * 2u));
#pragma unroll
        for (int ai = 0; ai < 2; ++ai)
#pragma unroll
            for (int m = 0; m < 4; ++m) { const int row = row0 + ai * HALF + m * 16; const float rs = PG8_ROW_RS(lds0, u, row);
                const unsigned P = (((unsigned)(row >> 7) * (unsigned)(ldc >> 6) + (unsigned)(u.pn * 4 + wc)) * 8192u + (unsigned)(((row - odd) & 127) * 64 + 8 * fq + odd * 32)) * 2u;
                u32x4 w[2];
#pragma unroll
                for (int bj = 0; bj < 2; ++bj) { f32x4 v0 = acc[ai][bj][m][0] * rs, v1 = acc[ai][bj][m][1] * rs;
                    if (ACT == 1) {
#pragma unroll
                        for (int j = 0; j < 4; ++j) { const float a = fmaxf(v0[j], 0.f), b = fmaxf(v1[j], 0.f); v0[j] = a * a; v1[j] = b * b; } }
                    w[bj].x = cvt_pk_bf16(v0[0], v0[1]); w[bj].y = cvt_pk_bf16(v0[2], v0[3]); w[bj].z = cvt_pk_bf16(v1[0], v1[1]); w[bj].w = cvt_pk_bf16(v1[2], v1[3]); }
                u32x4 sa, sb; PG8_FULL_LINE(w[0], w[1], odd, sa, sb);
                st16_wt(orr, P, sa); st16_wt(orr, P + 128u, sb); }
    }
};
struct EpiResid {
    static constexpr bool PERM = true, AFTER_DRAIN = false;
    bf16_t* xb; float* out32; float* ssq;
    __device__ __forceinline__ void operator()(const f32x4 (&acc)[2][2][4][2], const Unit& u, int wr, int wc, int fr, int fq) const {
        const int row0 = u.pm * BM + wr * 64 + fr, col0 = u.pn * BM + wc * 64 + 8 * fq;
        const int odd = fr & 1;
#define PG8_XBOFF(row_, col_) ((size_t)(((row_) >> 7) * 16 + ((col_) >> 6)) * 8192 + ((row_) & 127) * 64 + ((col_) & 63))
#define PG8_XUNPACK(r_, x0_, x1_) \
        f32x4 x0_ = (f32x4){__uint_as_float(r_.x << 16), __uint_as_float(r_.x & 0xffff0000u), __uint_as_float(r_.y << 16), __uint_as_float(r_.y & 0xffff0000u)}; \
        f32x4 x1_ = (f32x4){__uint_as_float(r_.z << 16), __uint_as_float(r_.z & 0xffff0000u), __uint_as_float(r_.w << 16), __uint_as_float(r_.w & 0xffff0000u)};
        if (out32 == nullptr) {
#pragma unroll
            for (int ai = 0; ai < 2; ++ai) {
                u32x4 xr[4][2];
#pragma unroll
                for (int m = 0; m < 4; ++m)
#pragma unroll
                    for (int bj = 0; bj < 2; ++bj) xr[m][bj] = *(const u32x4*)(xb + PG8_XBOFF(row0 - odd + bj + ai * HALF + m * 16, col0 + odd * 32));
#pragma unroll
                for (int m = 0; m < 4; ++m) { const int row = row0 + ai * HALF + m * 16; const size_t off = (size_t)row * 1024 + col0; float sq = 0.f;
                    u32x4 xo[2], w[2]; PG8_FULL_LINE(xr[m][0], xr[m][1], odd, xo[0], xo[1]);
#pragma unroll
                    for (int bj = 0; bj < 2; ++bj) { const u32x4 r = xo[bj]; PG8_XUNPACK(r, x0, x1)
                        x0 = x0 + acc[ai][bj][m][0]; x1 = x1 + acc[ai][bj][m][1];
                        sq += ((x0[0] * x0[0] + x0[1] * x0[1]) + (x0[2] * x0[2] + x0[3] * x0[3])) + ((x1[0] * x1[0] + x1[1] * x1[1]) + (x1[2] * x1[2] + x1[3] * x1[3]));
                        w[bj].x = cvt_pk_bf16(x0[0], x0[1]); w[bj].y = cvt_pk_bf16(x0[2], x0[3]); w[bj].z = cvt_pk_bf16(x1[0], x1[1]); w[bj].w = cvt_pk_bf16(x1[2], x1[3]); }
                    { u32x4 sa, sb; PG8_FULL_LINE(w[0], w[1], odd, sa, sb); bf16_t* P = xb + PG8_XBOFF(row - odd, col0 + odd * 32); *(u32x4*)P = sa; *(u32x4*)(P + 64) = sb; }
                    sq += __shfl_xor(sq, 16); sq += __shfl_xor(sq, 32); if (fq == 0) ssq[(size_t)row * 16 + u.pn * 4 + wc] = sq; }
                asm volatile("" ::: "memory"); }
        } else {
#pragma unroll
            for (int ai = 0; ai < 2; ++ai) {
                u32x4 xr[4][2];
#pragma unroll
                for (int m = 0; m < 4; ++m)
#pragma unroll
                    for (int bj = 0; bj < 2; ++bj) xr[m][bj] = *(const u32x4*)(xb + PG8_XBOFF(row0 - odd + bj + ai * HALF + m * 16, col0 + odd * 32));
#pragma unroll
                for (int m = 0; m < 4; ++m) { const size_t off = (size_t)(row0 + ai * HALF + m * 16) * 1024 + col0; u32x4 xo[2]; PG8_FULL_LINE(xr[m][0], xr[m][1], odd, xo[0], xo[1]);
#pragma unroll
                    for (int bj = 0; bj < 2; ++bj) { const u32x4 r = xo[bj]; PG8_XUNPACK(r, x0, x1)
                        x0 = x0 + acc[ai][bj][m][0]; x1 = x1 + acc[ai][bj][m][1];
                        *(f32x4*)(out32 + off + bj * 32) = x0; *(f32x4*)(out32 + off + bj * 32 + 4) = x1; } }
                asm volatile("" ::: "memory"); }
        }
#undef PG8_XUNPACK
#undef PG8_XBOFF
    }
};

__host__ __device__ __forceinline__ int inproj_srccol(int rho) {
    const int gi = rho >> 5, tile = gi >> 3, w8 = gi & 7, wc = w8 >> 1, bj = w8 & 1;
    if (tile == 11 || tile == 12) return (bj ? 3072 : 2816) + 128 * (tile - 11) + 32 * wc;
    return rho;
}
struct EpiInProj {
    static constexpr bool PERM = true, AFTER_DRAIN = false;
    PG8_LAS unsigned char* lds0; unsigned char* ws; const float* gq; const float* gk; const float* pwb;
    size_t oQS, oKS, oVS, oRQ, oRK, oRV, oRG, oHC, oROT; float c2, eps;
    __device__ __forceinline__ void operator()(const f32x4 (&acc)[2][2][4][2], const Unit& u, int wr, int wc, int fr, int fq) const {
        const int pn = u.pn, rowb = u.pm * BM + wr * 64 + fr;
        f32x4 cv[2][2];
#pragma unroll
        for (int bj = 0; bj < 2; ++bj)
#pragma unroll
            for (int n = 0; n < 2; ++n) cv[bj][n] = (f32x4){0.f, 0.f, 0.f, 0.f};
        if (pn < 2) { const float* g = pn ? gk : gq;
#pragma unroll
            for (int bj = 0; bj < 2; ++bj)
#pragma unroll
                for (int n = 0; n < 2; ++n) cv[bj][n] = *(const f32x4*)(g + 32 * bj + 8 * fq + 4 * n); }
        else if (pn >= 11) {
#pragma unroll
            for (int bj = 0; bj < 2; ++bj)
#pragma unroll
                for (int n = 0; n < 2; ++n) cv[bj][n] = *(const f32x4*)(pwb + 256 * bj + 128 * (pn - 11) + 32 * wc + 8 * fq + 4 * n); }
        float ifr[2][4];
#pragma unroll
        for (int bj = 0; bj < 2; ++bj)
#pragma unroll
            for (int p = 0; p < 4; ++p) ifr[bj][p] = __builtin_amdgcn_exp2f(-(float)(16 * bj + 4 * fq + p) * (13.287712379549449f / 31.0f)) * 0.15915494309189535f;
#pragma unroll
        for (int ai = 0; ai < 2; ++ai)
#pragma unroll
            for (int m = 0; m < 4; ++m) {
                const int row = rowb + ai * HALF + m * 16, b = row >> 12, t = row & 4095; const float rs = PG8_ROW_RS(lds0, u, row);
                f32x4 v[2][2];
#pragma unroll
                for (int bj = 0; bj < 2; ++bj)
#pragma unroll
                    for (int n = 0; n < 2; ++n) v[bj][n] = acc[ai][bj][m][n] * rs;
                if (pn < 2) {
                    float ss = 0.f;
#pragma unroll
                    for (int bj = 0; bj < 2; ++bj)
#pragma unroll
                        for (int n = 0; n < 2; ++n) ss += (v[bj][n][0] * v[bj][n][0] + v[bj][n][1] * v[bj][n][1]) + (v[bj][n][2] * v[bj][n][2] + v[bj][n][3] * v[bj][n][3]);
                    ss += __shfl_xor(ss, 16); ss += __shfl_xor(ss, 32);
                    float r = __builtin_amdgcn_rsqf(ss * (1.0f / 64.0f) + eps); if (pn == 0) r *= c2;
                    bf16_t* dst = (bf16_t*)(ws + (pn ? oKS : oQS)) + ((size_t)(b * 4 + wc) * 4096 + t) * 64 + 8 * fq;
#pragma unroll
                    for (int bj = 0; bj < 2; ++bj) { const f32x4 y0 = v[bj][0] * r * cv[bj][0], y1 = v[bj][1] * r * cv[bj][1];
                        u32x4 w; w.x = cvt_pk_bf16(y0[0], y0[1]); w.y = cvt_pk_bf16(y0[2], y0[3]); w.z = cvt_pk_bf16(y1[0], y1[1]); w.w = cvt_pk_bf16(y1[2], y1[3]); *(u32x4*)(dst + 32 * bj) = w; }
                } else if (pn == 2) {
#pragma unroll
                    for (int bj = 0; bj < 2; ++bj) { bf16_t* dst = (bf16_t*)(ws + oVS) + ((size_t)(b * 4 + wc) * 4096 + t) * 64 + 32 * bj + 8 * fq;
                        u32x4 w; w.x = cvt_pk_bf16(v[bj][0][0], v[bj][0][1]); w.y = cvt_pk_bf16(v[bj][0][2], v[bj][0][3]); w.z = cvt_pk_bf16(v[bj][1][0], v[bj][1][1]); w.w = cvt_pk_bf16(v[bj][1][2], v[bj][1][3]); *(u32x4*)dst = w; }
                } else if (pn < 7) {
                    const float sc = pn >= 5 ? 0.125f : 1.0f; const int head = 4 * ((pn - 3) & 1) + wc; const float tf = (float)t;
#pragma unroll
                    for (int bj = 0; bj < 2; ++bj) { float cs[4], sn[4];
#pragma unroll
                        for (int p = 0; p < 4; ++p) { const float rev = __builtin_amdgcn_fractf(tf * ifr[bj][p]); cs[p] = __builtin_amdgcn_cosf(rev) * sc; sn[p] = __builtin_amdgcn_sinf(rev) * sc; }
                        bf16_t* dst = (bf16_t*)(ws + (pn >= 5 ? oRK : oRQ)) + ((size_t)(b * 8 + head) * 4096 + t) * 64 + 32 * bj + 8 * fq;
                        const f32x4 a = v[bj][0], c = v[bj][1]; u32x4 w;
                        w.x = cvt_pk_bf16(a[0] * cs[0] - a[1] * sn[0], a[0] * sn[0] + a[1] * cs[0]); w.y = cvt_pk_bf16(a[2] * cs[1] - a[3] * sn[1], a[2] * sn[1] + a[3] * cs[1]);
                        w.z = cvt_pk_bf16(c[0] * cs[2] - c[1] * sn[2], c[0] * sn[2] + c[1] * cs[2]); w.w = cvt_pk_bf16(c[2] * cs[3] - c[3] * sn[3], c[2] * sn[3] + c[3] * cs[3]);
                        *(u32x4*)dst = w; }
                } else if (pn < 9) {
                    const int head = 4 * (pn - 7) + wc; const float lg2 = __builtin_amdgcn_logf(1.0f - __builtin_amdgcn_exp2f(-5.0f - (float)head)); const float sc = __builtin_amdgcn_exp2f(-(float)(t & 63) * lg2);
#pragma unroll
                    for (int bj = 0; bj < 2; ++bj) { bf16_t* dst = (bf16_t*)(ws + oRV) + ((size_t)(b * 8 + head) * 4096 + t) * 64 + 32 * bj + 8 * fq; const f32x4 a = v[bj][0] * sc, c = v[bj][1] * sc;
                        u32x4 w; w.x = cvt_pk_bf16(a[0], a[1]); w.y = cvt_pk_bf16(a[2], a[3]); w.z = cvt_pk_bf16(c[0], c[1]); w.w = cvt_pk_bf16(c[2], c[3]); *(u32x4*)dst = w; }
                } else if (pn < 11) {
#pragma unroll
                    for (int bj = 0; bj < 2; ++bj) { bf16_t* dst = (bf16_t*)(ws + oRG) + (size_t)row * 512 + 256 * (pn - 9) + 64 * wc + 32 * bj + 8 * fq; f32x4 a = v[bj][0], c = v[bj][1];
#pragma unroll
                        for (int j = 0; j < 4; ++j) { a[j] = a[j] * __builtin_amdgcn_rcpf(1.0f + __builtin_amdgcn_exp2f(-1.4426950408889634f * a[j])); c[j] = c[j] * __builtin_amdgcn_rcpf(1.0f + __builtin_amdgcn_exp2f(-1.4426950408889634f * c[j])); }
                        u32x4 w; w.x = cvt_pk_bf16(a[0], a[1]); w.y = cvt_pk_bf16(a[2], a[3]); w.z = cvt_pk_bf16(c[0], c[1]); w.w = cvt_pk_bf16(c[2], c[3]); *(u32x4*)dst = w; }
                } else {
                    bf16_t* dst = (bf16_t*)(ws + oHC) + (size_t)row * 256 + 128 * (pn - 11) + 32 * wc + 8 * fq; f32x4 h[2];
#pragma unroll
                    for (int n = 0; n < 2; ++n) { const f32x4 a = v[0][n] + cv[0][n], g = v[1][n] + cv[1][n];
#pragma unroll
                        for (int j = 0; j < 4; ++j) h[n][j] = a[j] * __builtin_amdgcn_rcpf(1.0f + __builtin_amdgcn_exp2f(-1.4426950408889634f * g[j])); }
                    u32x4 w; w.x = cvt_pk_bf16(h[0][0], h[0][1]); w.y = cvt_pk_bf16(h[0][2], h[0][3]); w.z = cvt_pk_bf16(h[1][0], h[1][1]); w.w = cvt_pk_bf16(h[1][2], h[1][3]); *(u32x4*)dst = w;
                }
            }
    }
};

template <class Epi, class Sched, bool ALIGN_EPI = false, bool SP2 = false>
__device__ __forceinline__ void gemm_phase(PG8_LAS unsigned char* lds, const Gemm g, const Sched& S, const Epi& E) {
    int tid_ = threadIdx.x; asm volatile("" : "+v"(tid_));
    const int tid = tid_, wid = __builtin_amdgcn_readfirstlane(tid >> 6), lane = tid & 63, wr = wid >> 2, wc = wid & 3, fr = lane & 15, fq = lane >> 4;
    const int K = g.K, nt = K / BK;
    unsigned voffA[2], voffB[2];
#pragma unroll
    for (int i = 0; i < 2; ++i) { int R, C; stage_rc(tid * 16 + i * 8192, R, C); const int Rb = Epi::PERM ? (64 * (R >> 5) + perm32(R & 31)) : R;
        voffA[i] = (unsigned)(R * (g.a_blocked ? BK : K) + C) * 2u; voffB[i] = (unsigned)(Rb * K + C) * 2u; }
    const size_t kstep = (size_t)(BK * 2);
    const size_t hstep = (size_t)HALF * K * 2;
    const size_t tstep = 2 * hstep;
    const size_t hstepB = Epi::PERM ? (size_t)32 * K * 2 : hstep;
    const size_t kstepA = g.a_blocked ? (size_t)(HALF * BK * 2) : kstep, hstepA = g.a_blocked ? (size_t)(K / BK) * (HALF * BK * 2) : hstep, tstepA = 2 * hstepA;
    const unsigned ldsw = (unsigned)wid * 1024u;
    const int aoff = lds_byte(wr * 64 + fr, fq * 8), boff = lds_byte(wc * 32 + fr, fq * 8);
#define PG8_SA(b, h) (((b) * 2 + (h)) * HTB)
#define PG8_SB(b, h) ((4 + (b) * 2 + (h)) * HTB)
#define PG8_STAGE(bufoff, gbase, voff) do { _Pragma("unroll") for (int _i = 0; _i < 2; ++_i) \
        __builtin_amdgcn_global_load_lds((const unsigned*)((const char*)(gbase) + (voff)[_i]), (PG8_LAS unsigned*)(lds + (bufoff) + ldsw + _i * 8192), 16, 0, 0); } while (0)
#define PG8_LDA(dst, b, h) do { _Pragma("unroll") for (int m = 0; m < 4; ++m) _Pragma("unroll") for (int k = 0; k < 2; ++k) dst[m][k] = *(const PG8_LAS bf16x8*)(lds + PG8_SA(b, h) + aoff + m * 2048 + k * 1024); } while (0)
#define PG8_LDB(dst, b, h) do { _Pragma("unroll") for (int n = 0; n < 2; ++n) _Pragma("unroll") for (int k = 0; k < 2; ++k) dst[n][k] = *(const PG8_LAS bf16x8*)(lds + PG8_SB(b, h) + boff + n * 2048 + k * 1024); } while (0)
#define PG8_MMA(ai, bj, At, Bt) do { __builtin_amdgcn_s_setprio(1); _Pragma("unroll") for (int m = 0; m < 4; ++m) _Pragma("unroll") for (int n = 0; n < 2; ++n) _Pragma("unroll") for (int k = 0; k < 2; ++k) \
        acc[ai][bj][m][n] = __builtin_amdgcn_mfma_f32_16x16x32_bf16(Bt[n][k], At[m][k], acc[ai][bj][m][n], 0, 0, 0); __builtin_amdgcn_s_setprio(0); } while (0)
#define PG8_WAIT_V(n) asm volatile("s_waitcnt vmcnt(" #n ")" ::: "memory")
#define PG8_WAIT_L(n) asm volatile("s_waitcnt lgkmcnt(" #n ")" ::: "memory")
#define PG8_BAR __builtin_amdgcn_s_barrier()
#define PG8_SCHED __builtin_amdgcn_sched_barrier(0)
    Unit cur, nxt; int ui = 0;
    if (!S.next(0, cur)) return;
    f32x4 acc[2][2][4][2];
#pragma unroll
    for (int a = 0; a < 2; ++a)
#pragma unroll
        for (int b = 0; b < 2; ++b)
#pragma unroll
            for (int m = 0; m < 4; ++m)
#pragma unroll
                for (int n = 0; n < 2; ++n) acc[a][b][m][n] = (f32x4){0.f, 0.f, 0.f, 0.f};
    bf16x8 At[4][2], B0[2][2], B1[2][2];
    const char* cA = (const char*)g.A + (size_t)cur.pm * tstepA; const char* cB = (const char*)g.Bt + (size_t)cur.pn * tstep;
    S.a_ready(cur);
    if constexpr (SP2) {
        PG8_STAGE(PG8_SB(0, 0), cB, voffB); PG8_STAGE(PG8_SB(0, 1), cB + hstepB, voffB); PG8_STAGE(PG8_SA(0, 0), cA, voffA); PG8_STAGE(PG8_SA(0, 1), cA + hstepA, voffA);
        if (wr == 1) PG8_BAR;
        PG8_WAIT_V(2); PG8_BAR;
        PG8_STAGE(PG8_SB(1, 0), cB + kstep, voffB); PG8_STAGE(PG8_SA(1, 0), cA + kstepA, voffA); PG8_STAGE(PG8_SB(1, 1), cB + hstepB + kstep, voffB);
        PG8_WAIT_V(6); PG8_BAR;
    } else {
        PG8_STAGE(PG8_SB(0, 0), cB, voffB); PG8_STAGE(PG8_SA(0, 0), cA, voffA); PG8_STAGE(PG8_SB(0, 1), cB + hstepB, voffB); PG8_STAGE(PG8_SA(0, 1), cA + hstepA, voffA);
        if (wr == 1) PG8_BAR;
        PG8_WAIT_V(4); PG8_BAR;
        PG8_STAGE(PG8_SB(1, 0), cB + kstep, voffB); PG8_STAGE(PG8_SA(1, 0), cA + kstepA, voffA); PG8_STAGE(PG8_SB(1, 1), cB + hstepB + kstep, voffB);
        PG8_WAIT_V(6); PG8_BAR;
    }
    for (;;) {
        const bool has_next = S.next(ui + 1, nxt);
        const char* nA = has_next ? (const char*)g.A + (size_t)nxt.pm * tstepA : cA; const char* nB = has_next ? (const char*)g.Bt + (size_t)nxt.pn * tstep : cB;
        for (int t = 0; t < nt; t += 2) {
            const bool last = (t == nt - 2);
            const char* a1 = cA + (size_t)(t + 1) * kstepA;
            const char* a2 = last ? nA : cA + (size_t)(t + 2) * kstepA; const char* b2 = last ? nB : cB + (size_t)(t + 2) * kstep;
            const char* a3 = a2 + kstepA; const char* b3 = b2 + kstep;
            if (last && has_next) S.a_ready(nxt);
            if constexpr (SP2) {
            PG8_LDB(B0, 0, 0); PG8_LDB(B1, 0, 1); PG8_SCHED; PG8_LDA(At, 0, 0); PG8_STAGE(PG8_SA(1, 1), a1 + hstepA, voffA);
            PG8_WAIT_V(8); PG8_WAIT_L(0); PG8_BAR; PG8_MMA(0, 0, At, B0); PG8_MMA(0, 1, At, B1); PG8_BAR; PG8_SCHED;
            PG8_LDA(At, 0, 1); PG8_STAGE(PG8_SB(0, 0), b2, voffB); PG8_STAGE(PG8_SB(0, 1), b2 + hstepB, voffB); PG8_STAGE(PG8_SA(0, 0), a2, voffA);
            PG8_WAIT_V(8); PG8_WAIT_L(0); PG8_BAR; PG8_MMA(1, 0, At, B0); PG8_MMA(1, 1, At, B1); PG8_BAR; PG8_SCHED;
            PG8_LDB(B0, 1, 0); PG8_LDB(B1, 1, 1); PG8_SCHED; PG8_LDA(At, 1, 0); PG8_STAGE(PG8_SA(0, 1), a2 + hstepA, voffA);
            PG8_WAIT_V(8); PG8_WAIT_L(0); PG8_BAR; PG8_MMA(0, 0, At, B0); PG8_MMA(0, 1, At, B1); PG8_BAR; PG8_SCHED;
            PG8_LDA(At, 1, 1); PG8_STAGE(PG8_SB(1, 0), b3, voffB); PG8_STAGE(PG8_SB(1, 1), b3 + hstepB, voffB); PG8_STAGE(PG8_SA(1, 0), a3, voffA);
            PG8_WAIT_V(8); PG8_WAIT_L(0); PG8_BAR; PG8_MMA(1, 0, At, B0); PG8_MMA(1, 1, At, B1); PG8_BAR; PG8_SCHED;
            } else {
            PG8_LDB(B0, 0, 0); PG8_SCHED; PG8_LDA(At, 0, 0); PG8_STAGE(PG8_SA(1, 1), a1 + hstepA, voffA);
            PG8_WAIT_L(8); PG8_BAR; PG8_WAIT_L(0); PG8_MMA(0, 0, At, B0); PG8_BAR; PG8_SCHED;
            PG8_LDB(B1, 0, 1); PG8_STAGE(PG8_SB(0, 0), b2, voffB);
            PG8_BAR; PG8_WAIT_L(0); PG8_MMA(0, 1, At, B1); PG8_BAR;
            PG8_LDA(At, 0, 1); PG8_STAGE(PG8_SA(0, 0), a2, voffA);
            PG8_BAR; PG8_WAIT_L(0); PG8_MMA(1, 0, At, B0); PG8_BAR; PG8_SCHED;
            PG8_STAGE(PG8_SB(0, 1), b2 + hstepB, voffB);
            PG8_WAIT_V(6); PG8_BAR; PG8_MMA(1, 1, At, B1); PG8_BAR;
            PG8_LDB(B0, 1, 0); PG8_SCHED; PG8_LDA(At, 1, 0); PG8_STAGE(PG8_SA(0, 1), a2 + hstepA, voffA);
            PG8_WAIT_L(8); PG8_BAR; PG8_WAIT_L(0); PG8_MMA(0, 0, At, B0); PG8_BAR; PG8_SCHED;
            PG8_LDB(B1, 1, 1); PG8_STAGE(PG8_SB(1, 0), b3, voffB);
            PG8_BAR; PG8_WAIT_L(0); PG8_MMA(0, 1, At, B1); PG8_BAR;
            PG8_LDA(At, 1, 1); PG8_STAGE(PG8_SA(1, 0), a3, voffA);
            PG8_BAR; PG8_WAIT_L(0); PG8_MMA(1, 0, At, B0); PG8_BAR; PG8_SCHED;
            PG8_STAGE(PG8_SB(1, 1), b3 + hstepB, voffB);
            PG8_WAIT_V(6); PG8_BAR; PG8_MMA(1, 1, At, B1); PG8_BAR;
            }
        }
        if constexpr (ALIGN_EPI) { if (wr == 0) PG8_BAR; }
        if constexpr (!Epi::AFTER_DRAIN) { E(acc, cur, wr, wc, fr, fq); S.done(cur); }
        if (!has_next) break;
#pragma unroll
        for (int a = 0; a < 2; ++a)
#pragma unroll
            for (int b = 0; b < 2; ++b)
#pragma unroll
                for (int m = 0; m < 4; ++m)
#pragma unroll
                    for (int n = 0; n < 2; ++n) acc[a][b][m][n] = (f32x4){0.f, 0.f, 0.f, 0.f};
        cur = nxt; cA = nA; cB = nB; ++ui;
        if constexpr (ALIGN_EPI) { if (wr == 1) PG8_BAR; }
    }
    PG8_WAIT_V(0);
    if constexpr (!ALIGN_EPI) { if (wr == 0) PG8_BAR; }
    PG8_BAR;
    if constexpr (Epi::AFTER_DRAIN) { E.fused(acc, cur, wr, wc, fr, fq, lds, wid, lane); S.done(cur); }
#undef PG8_SA
#undef PG8_SB
#undef PG8_STAGE
#undef PG8_LDA
#undef PG8_LDB
#undef PG8_MMA
#undef PG8_WAIT_V
#undef PG8_WAIT_L
#undef PG8_BAR
#undef PG8_SCHED
}
}
#ifndef PG8_SP2
#define PG8_SP2 true
#endif
#ifndef PG8_ALIGN
#define PG8_ALIGN true
#endif

constexpr int NWAVES = 8;
constexpr int BATCH = 8, SEQ = 4096, DM = 1024, DEPTH = 2, M = BATCH * SEQ;
constexpr int HD = 64, SBH = 4, SBW = 256, RH = 8, RW = 512, CW = 256, CK = 31, DFF = 4096, INC = 3328;
constexpr float EPS = 1e-6f;
constexpr float SB_C2 = 0.125f * 1.4426950408889634f;
constexpr size_t MiB = 1u << 20;
constexpr size_t WS_CTL = 0, CTL_ZERO_BYTES = 32768;
constexpr size_t WS_W = 2 * MiB, W_LAYER = 25 * MiB, W_IN = 0, W_OUT = 7 * MiB, W_1 = 9 * MiB, W_2 = 17 * MiB;
constexpr size_t WS_SSQ = 53 * MiB;
constexpr size_t WS_XNG = 56 * MiB;
constexpr size_t WS_RT = 216 * MiB;
constexpr size_t WS_RQT = 232 * MiB;
constexpr size_t WS_RG = 184 * MiB;
constexpr size_t WS_R = 120 * MiB;
constexpr size_t WS_MIX = WS_R, WS_F = WS_R;
constexpr size_t WS_QS = 328 * MiB, WS_KS = 344 * MiB, WS_VS = 360 * MiB;
constexpr size_t WS_RQ = 376 * MiB, WS_RK = 408 * MiB, WS_RV = 440 * MiB;
constexpr size_t WS_HC = 472 * MiB;
constexpr size_t WS_END = 488 * MiB;
static_assert(WS_RQT + 4 * MiB <= WS_QS && WS_F + (size_t)M * DFF * 2 <= WS_HC && WS_HC + (size_t)M * CW * 2 <= WS_END, "d_ws map");
constexpr int CW_BAR = 4096;
constexpr int RING_OFF = 0, RING_BYTES = 131072, LDSCTL_OFF = RING_BYTES, MISC_OFF = LDSCTL_OFF + 320, LDS_BYTES = 147456;

#define GAS __attribute__((address_space(1)))
#define LAS __attribute__((address_space(3)))
typedef unsigned short bf16;
typedef unsigned v4u __attribute__((ext_vector_type(4)));
typedef unsigned v2u __attribute__((ext_vector_type(2)));
typedef float f32x4 __attribute__((ext_vector_type(4)));
#define LDS_WAIT() asm volatile("s_waitcnt lgkmcnt(0)" ::: "memory")
#define VM_WAIT() asm volatile("s_waitcnt vmcnt(0)" ::: "memory")
__device__ __forceinline__ float bf2f(unsigned h) { return __uint_as_float(h << 16); }
__device__ __forceinline__ float bflo(unsigned w) { return __uint_as_float(w << 16); }
__device__ __forceinline__ float bfhi(unsigned w) { return __uint_as_float(w & 0xffff0000u); }
__device__ __forceinline__ unsigned pk2(float lo, float hi) { return pg8::cvt_pk_bf16(lo, hi); }
__device__ __forceinline__ float wave_sum(float v) {
#pragma unroll
    for (int o = 1; o < 64; o <<= 1) v += __shfl_xor(v, o);
    return v;
}

#define XB_TMO      128
#define XB_XCNT(j)  (256  + 64 * (j))
#define XB_XSUB(j)  (1280 + 64 * (j))
#define XB_XGEN(j)  (2304 + 64 * (j))
#define XB_TOP      3328
#define XB_TOPGEN   3392
#define XCD_BAR_WORDS 3456
#define XB_SPIN_CAP (1u << 18)

__device__ __forceinline__ unsigned xb_ld(unsigned* p)              { return __hip_atomic_load(p, __ATOMIC_RELAXED, __HIP_MEMORY_SCOPE_AGENT); }
__device__ __forceinline__ unsigned xb_add(unsigned* p, unsigned v) { return __hip_atomic_fetch_add(p, v, __ATOMIC_RELAXED, __HIP_MEMORY_SCOPE_AGENT); }
__device__ __forceinline__ unsigned xb_xcc_id() { return (unsigned)__builtin_amdgcn_s_getreg((3 << 11) | 20) & 0xFu; }
#define XB_SPIN(cond, bar) do { unsigned _sp = 0; while (cond) { __builtin_amdgcn_s_sleep(1); \
    if ((++_sp & 255u) == 0u) { if (xb_ld(&(bar)[XB_TMO])) break; if (_sp > XB_SPIN_CAP) { atomicAdd(&(bar)[XB_TMO], 1u); break; } } } } while (0)

struct XcdBarrier {
    unsigned* bar; unsigned x;
    volatile LAS unsigned* st;
};

__device__ __forceinline__ XcdBarrier xcd_barrier_post(unsigned* bar, volatile LAS unsigned* st) {
    XcdBarrier b; b.bar = bar; b.x = xb_xcc_id(); b.st = st;
    if (threadIdx.x == 0) (void)xb_add(&bar[XB_XCNT(b.x)], 1u);
    return b;
}
__device__ __forceinline__ void xcd_barrier_complete(unsigned* bar, unsigned x, unsigned& nloc, unsigned& nx) {
    const unsigned G = gridDim.x * gridDim.y * gridDim.z;
    unsigned sum, cnt, mine, sp = 0u;
    for (;;) {
        sum = 0u; cnt = 0u; mine = 0u;
#pragma unroll
        for (unsigned j = 0; j < 16; ++j) { const unsigned c = xb_ld(&bar[XB_XCNT(j)]); sum += c; cnt += (c > 0u) ? 1u : 0u; mine = (j == x) ? c : mine; }
        if (sum == G) break;
        __builtin_amdgcn_s_sleep(1);
        if ((++sp & 255u) == 0u) { if (xb_ld(&bar[XB_TMO])) break; if (sp > XB_SPIN_CAP) { atomicAdd(&bar[XB_TMO], 1u); break; } }
    }
    nloc = mine > 0u ? mine : 1u; nx = cnt > 0u ? cnt : 1u;
}

__device__ __forceinline__ void xcd_barrier(const XcdBarrier& b) {
    asm volatile("s_waitcnt vmcnt(0)" ::: "memory");
    __syncthreads();
    if (threadIdx.x == 0) {
        unsigned* bar = b.bar;
        __builtin_amdgcn_s_waitcnt(0);
        unsigned nloc = b.st[0], nx = b.st[1];
        if (nloc == 0u) { xcd_barrier_complete(bar, b.x, nloc, nx); b.st[0] = nloc; b.st[1] = nx; }
        const unsigned old = xb_add(&bar[XB_XSUB(b.x)], 1u);
        const unsigned gen = old / nloc;
        if (old + 1u == (gen + 1u) * nloc) {
            __builtin_amdgcn_fence(__ATOMIC_RELEASE, "agent");
            asm volatile("s_waitcnt vmcnt(0)" ::: "memory");
            const unsigned og = xb_add(&bar[XB_TOP], 1u);
            const unsigned tg = og / nx;
            if (og + 1u == (tg + 1u) * nx) xb_add(&bar[XB_TOPGEN], 1u);
            else XB_SPIN(xb_ld(&bar[XB_TOPGEN]) == tg, bar);
            __builtin_amdgcn_fence(__ATOMIC_ACQUIRE, "agent");
            xb_add(&bar[XB_XGEN(b.x)], 1u);
            asm volatile("s_waitcnt vmcnt(0)" ::: "memory");
        } else {
            XB_SPIN(xb_ld(&bar[XB_XGEN(b.x)]) == gen, bar);
            __builtin_amdgcn_fence(__ATOMIC_ACQUIRE, "agent");
            asm volatile("s_waitcnt vmcnt(0)" ::: "memory");
        }
    }
    __syncthreads();
}

struct Args {
    const float* x; const float* mix_g; const float* w_in; const float* sbq_g; const float* sbk_g; const float* ret_g; const float* pw_b; const float* dw_w; const float* dw_b;
    const float* ln_g; const float* ln_b; const float* w_out; const float* mlp_g; const float* w_ff1; const float* w_ff2;
    float* out; unsigned char* ws;
    float ret_lg2[8];
    int ph_lo, ph_hi;
};

struct Frame {
    LAS unsigned char* lds;
    int tid, lane, wave, gw;
    unsigned char* ws;
};

template <bool INPROJ> __device__ __forceinline__ void p0_transpose_item(const float* W, const float* gk, int K, int N, bf16* WT, LAS float* scr, int item, int lane) {
    const int nblk = N / 32, kb = item / nblk, nb = item % nblk, k0 = 64 * kb, r0 = 32 * nb, n0 = INPROJ ? pg8::inproj_srccol(r0) : r0;
    float wv[32];
#pragma unroll
    for (int i = 0; i < 32; ++i) wv[i] = W[(size_t)(k0 + 2 * i + (lane >> 5)) * N + n0 + (lane & 31)];
    if (gk) {
#pragma unroll
        for (int i = 0; i < 32; ++i) wv[i] *= gk[k0 + 2 * i + (lane >> 5)]; }
#pragma unroll
    for (int i = 0; i < 32; ++i) scr[(2 * i + (lane >> 5)) * 33 + (lane & 31)] = wv[i];
    LDS_WAIT(); asm volatile("" ::: "memory");
    const int c = lane & 7;
#pragma unroll
    for (int j = 0; j < 4; ++j) { const int n = (lane >> 3) + 8 * j; const LAS float* s = scr + (8 * c) * 33 + n;
        v4u o; o.x = pk2(s[0 * 33], s[1 * 33]); o.y = pk2(s[2 * 33], s[3 * 33]); o.z = pk2(s[4 * 33], s[5 * 33]); o.w = pk2(s[6 * 33], s[7 * 33]);
        *(v4u*)(WT + (size_t)(r0 + n) * K + k0 + 8 * c) = o; }
    LDS_WAIT(); asm volatile("" ::: "memory");
}
__device__ __forceinline__ void xng_row2(const float* x, int m0, int m1, bf16* xb_all, float* ssq, int lane) {
    const f32x4* x0 = (const f32x4*)(x + (size_t)m0 * DM) + lane; const f32x4* x1 = (const f32x4*)(x + (size_t)m1 * DM) + lane;
    f32x4 v[2][4];
#pragma unroll
    for (int j = 0; j < 4; ++j) { v[0][j] = x0[64 * j]; v[1][j] = x1[64 * j]; }
#pragma unroll
    for (int r = 0; r < 2; ++r) { const int m_row = r ? m1 : m0; float s = 0.f;
#pragma unroll
        for (int j = 0; j < 4; ++j) s += (v[r][j][0] * v[r][j][0] + v[r][j][1] * v[r][j][1]) + (v[r][j][2] * v[r][j][2] + v[r][j][3] * v[r][j][3]);
        s = wave_sum(s);
#pragma unroll
        for (int j = 0; j < 4; ++j) { const f32x4 y = v[r][j]; v2u w; w.x = pk2(y[0], y[1]); w.y = pk2(y[2], y[3]); const int c = 4 * lane + 256 * j;
            *(v2u*)(xb_all + ((size_t)((m_row >> 7) * 16 + (c >> 6)) * 8192 + (m_row & 127) * 64 + (c & 63))) = w; }
        if (lane < 16) ssq[(size_t)m_row * 16 + lane] = lane == 0 ? s : 0.f; }
}
__device__ __forceinline__ void convert_weights(Frame& F, const Args& A, int l_lo, int l_hi, int stride_id, int stride) {
    LAS float* scr = (LAS float*)(F.lds + RING_OFF + F.wave * 16384);
    constexpr int I_IN = (DM / 64) * (INC / 32), I_OUT = (DM / 64) * (DM / 32), I_1 = (DM / 64) * (DFF / 32), I_2 = (DFF / 64) * (DM / 32), I_L = I_IN + I_OUT + I_1 + I_2;
    const int first = l_lo * I_L, last = l_hi * I_L;
    for (int it = first + stride_id; it < last; it += stride) {
        const int l = it / I_L; int r = it % I_L; unsigned char* wl = F.ws + WS_W + (size_t)l * W_LAYER;
        if (r < I_IN) { p0_transpose_item<true>(A.w_in + (size_t)l * DM * INC, A.mix_g + l * DM, DM, INC, (bf16*)(wl + W_IN), scr, r, F.lane); continue; } r -= I_IN;
        if (r < I_OUT) { p0_transpose_item<false>(A.w_out + (size_t)l * DM * DM, nullptr, DM, DM, (bf16*)(wl + W_OUT), scr, r, F.lane); continue; } r -= I_OUT;
        if (r < I_1) { p0_transpose_item<false>(A.w_ff1 + (size_t)l * DM * DFF, A.mlp_g + l * DM, DM, DFF, (bf16*)(wl + W_1), scr, r, F.lane); continue; } r -= I_1;
        p0_transpose_item<false>(A.w_ff2 + (size_t)l * DFF * DM, nullptr, DFF, DM, (bf16*)(wl + W_2), scr, r, F.lane);
    }
}
__device__ __forceinline__ void p0_prologue(Frame& F, const Args& A) {
    const int NGW = gridDim.x * NWAVES;
    convert_weights(F, A, 0, 1, F.gw, NGW);
    for (int m = F.gw; m < M / 2; m += NGW) {
        xng_row2(A.x, m, m + M / 2, (bf16*)(F.ws + WS_XNG), (float*)(F.ws + WS_SSQ), F.lane); }
}

__device__ __forceinline__ float sigmoidf_(float x) { return 1.0f / (1.0f + __expf(-x)); }

namespace sba {
typedef short bf16x8 __attribute__((ext_vector_type(8)));
typedef short s16x4 __attribute__((ext_vector_type(4)));
typedef float f32x16 __attribute__((ext_vector_type(16)));
typedef unsigned u32x4 __attribute__((ext_vector_type(4)));
typedef float f32x2_t __attribute__((ext_vector_type(2))); typedef __bf16 bf16x2_t __attribute__((ext_vector_type(2)));
__device__ __forceinline__ unsigned cvtpk(float lo, float hi) { const f32x2_t v = {lo, hi}; const bf16x2_t b = __builtin_convertvector(v, bf16x2_t); return __builtin_bit_cast(unsigned, b); }
__device__ __forceinline__ bf16x8 frag8(const f32x16& x, int s) {
    u32x4 w; w.x = cvtpk(x[8 * s + 0], x[8 * s + 1]); w.y = cvtpk(x[8 * s + 2], x[8 * s + 3]); w.z = cvtpk(x[8 * s + 4], x[8 * s + 5]); w.w = cvtpk(x[8 * s + 6], x[8 * s + 7]);
    return __builtin_bit_cast(bf16x8, w);
}
__device__ __forceinline__ s16x4 vtr(const LAS unsigned char* p) { typedef short v4i16_t __attribute__((ext_vector_type(4))); return __builtin_bit_cast(s16x4, __builtin_amdgcn_ds_read_tr16_b64_v4i16((LAS v4i16_t*)p)); }
constexpr int SB_LDS = 65536; constexpr float SB_EXIT = 160.0f;

template <bool DIAG> __device__ __forceinline__ void sb_subtile(const LAS unsigned char* Kb, const LAS unsigned char* Vb, int hf, int r32, int hi, unsigned vlane, const bf16x8 (&qr)[4],
                                                                bf16x8 U0n, bf16x8 U1n, bf16x8 ONn, f32x16& o0, f32x16& o1, f32x16& carry) {
    f32x16 z;
#pragma unroll
    for (int r = 0; r < 16; ++r) z[r] = 0.f;
#pragma unroll
    for (int d0 = 0; d0 < 4; ++d0) { const bf16x8 kf = *(const LAS bf16x8*)(Kb + (2 * d0 + hi) * 1024 + (32 * hf + r32) * 16); z = __builtin_amdgcn_mfma_f32_32x32x16_bf16(kf, qr[d0], z, 0, 0, 0); }
    f32x16 sp;
#pragma unroll
    for (int r = 0; r < 16; ++r) { const float zz = z[r]; const float e = __builtin_amdgcn_exp2f(-fabsf(zz)); sp[r] = __builtin_fmaf(0.5f, zz + fabsf(zz), __builtin_amdgcn_logf(1.0f + e)); }
    if (DIAG) {
#pragma unroll
        for (int r = 0; r < 16; ++r) { const int keyl = (r & 3) + 8 * (r >> 2) + 4 * hi; if (!(keyl < r32)) sp[r] = 0.f; }
    }
    const bf16x8 x0 = frag8(sp, 0), x1 = frag8(sp, 1);
    f32x16 T = __builtin_amdgcn_mfma_f32_32x32x16_bf16(U0n, x0, carry, 0, 0, 0); T = __builtin_amdgcn_mfma_f32_32x32x16_bf16(U1n, x1, T, 0, 0, 0);
    carry = __builtin_amdgcn_mfma_f32_32x32x16_bf16(ONn, x0, carry, 0, 0, 0); carry = __builtin_amdgcn_mfma_f32_32x32x16_bf16(ONn, x1, carry, 0, 0, 0);
    f32x16 w;
#pragma unroll
    for (int r = 0; r < 16; ++r) w[r] = __builtin_amdgcn_exp2f(z[r] + T[r]);
    if (DIAG) {
#pragma unroll
        for (int r = 0; r < 16; ++r) { const int keyl = (r & 3) + 8 * (r >> 2) + 4 * hi; if (!(keyl < r32)) w[r] = 0.f; }
    }
    const bf16x8 w0 = frag8(w, 0), w1 = frag8(w, 1);
#pragma unroll
    for (int ks = 0; ks < 2; ++ks) { const LAS unsigned char* vp = Vb + vlane + (32 * hf + 16 * ks) * 64;
        const s16x4 a0 = vtr(vp), a1 = vtr(vp + 512), b0 = vtr(vp + 4096), b1 = vtr(vp + 4096 + 512);
        const bf16x8 v0 = (bf16x8){a0[0], a0[1], a0[2], a0[3], a1[0], a1[1], a1[2], a1[3]}, v1 = (bf16x8){b0[0], b0[1], b0[2], b0[3], b1[0], b1[1], b1[2], b1[3]};
        o0 = __builtin_amdgcn_mfma_f32_32x32x16_bf16(ks ? w1 : w0, v0, o0, 0, 0, 0); o1 = __builtin_amdgcn_mfma_f32_32x32x16_bf16(ks ? w1 : w0, v1, o1, 0, 0, 0); }
}
__device__ __forceinline__ void sb_unit(int bh, int qb, const bf16* Qs, const bf16* Ks, const bf16* Vs, bf16* MIX, LAS unsigned char* lds, int tid) {
    const int lane = tid & 63, wave = __builtin_amdgcn_readfirstlane(tid >> 6), r32 = lane & 31, hi = lane >> 5, quad = wave >> 2, tq = tid & 255;
    const int q0 = qb * 256 + quad * 128 + (quad ? 3 - (wave & 3) : (wave & 3)) * 32; const size_t hb = (size_t)bh * SEQ * HD;
    bf16x8 qr[4];
#pragma unroll
    for (int d0 = 0; d0 < 4; ++d0) qr[d0] = *(const bf16x8*)(Qs + hb + (size_t)(q0 + r32) * HD + 16 * d0 + 8 * hi);
    bf16x8 U0, U1, ON;
#pragma unroll
    for (int j = 0; j < 8; ++j) { const int k0 = 8 * (j >> 2) + 4 * hi + (j & 3); U0[j] = (k0 >= r32) ? (short)0xBF80 : (short)0; U1[j] = (16 + k0 >= r32) ? (short)0xBF80 : (short)0; ON[j] = (short)0xBF80; }
    f32x16 o0, o1, carry;
#pragma unroll
    for (int r = 0; r < 16; ++r) { o0[r] = 0.f; o1[r] = 0.f; carry[r] = 0.f; }
    const int NT = 4 * qb + 2 + 2 * quad, NSTEP = 4 * qb + 4;
    LAS unsigned char* ldq = lds + quad * 32768;
    unsigned kdst[2], vdst[2];
#pragma unroll
    for (int i = 0; i < 2; ++i) { const int p = tq + 256 * i, key_i = p >> 3, c_i = p & 7; kdst[i] = (unsigned)(c_i * 1024 + key_i * 16); vdst[i] = (unsigned)(8192 + (c_i >> 2) * 4096 + key_i * 64 + (c_i & 3) * 16); }
    const v4u* kg = (const v4u*)(Ks + hb) + tq; const v4u* vg = (const v4u*)(Vs + hb) + tq;
    {
#pragma unroll
        for (int i = 0; i < 2; ++i) { const v4u kx = kg[(size_t)(NT - 1) * 512 + 256 * i], vx = vg[(size_t)(NT - 1) * 512 + 256 * i]; *(LAS v4u*)(ldq + kdst[i]) = kx; *(LAS v4u*)(ldq + vdst[i]) = vx; } }
    __syncthreads();
    const unsigned vlane = (unsigned)(((lane >> 4) & 1) * 32 + (lane & 3) * 8 + (4 * hi + ((lane & 15) >> 2)) * 64);
    int cur = 0;
    for (int i = 0; i < NSTEP; ++i) {
        const int kt = NT - 1 - i;
        v4u kx[2], vx[2];
        if (kt > 0) {
#pragma unroll
            for (int j = 0; j < 2; ++j) { kx[j] = kg[(size_t)(kt - 1) * 512 + 256 * j]; vx[j] = vg[(size_t)(kt - 1) * 512 + 256 * j]; } }
        const bool wfin = __all(carry[0] <= -SB_EXIT);
        if (kt >= 0 && !wfin) {
            const LAS unsigned char* Kb = ldq + cur * 16384; const LAS unsigned char* Vb = Kb + 8192;
#pragma unroll
            for (int hf = 1; hf >= 0; --hf) {
                const int kbase = kt * 64 + hf * 32;
                if (kbase <= q0) {
                    if (kbase == q0) sb_subtile<true>(Kb, Vb, hf, r32, hi, vlane, qr, U0, U1, ON, o0, o1, carry);
                    else sb_subtile<false>(Kb, Vb, hf, r32, hi, vlane, qr, U0, U1, ON, o0, o1, carry);
                }
            }
        }
        if (kt > 0) {
#pragma unroll
            for (int j = 0; j < 2; ++j) { *(LAS v4u*)(ldq + (cur ^ 1) * 16384 + kdst[j]) = kx[j]; *(LAS v4u*)(ldq + (cur ^ 1) * 16384 + vdst[j]) = vx[j]; } }
        const int wdone = (kt <= 0) || ((kt * 64 <= q0) && __all(carry[0] <= -SB_EXIT));
        if (__syncthreads_and(wdone)) break;
        cur ^= 1;
    }
    const int b = bh >> 2, hh = bh & 3;
#pragma unroll
    for (int r = 0; r < 16; ++r) { const int t = q0 + (r & 3) + 8 * (r >> 2) + 4 * hi; bf16* dst = MIX + (((size_t)((b * SEQ + t) >> 7) * 16 + (hh)) * 8192 + ((b * SEQ + t) & 127) * 64 + (r32));
        dst[0] = (bf16)(cvtpk(o0[r], 0.f) & 0xffffu); dst[32] = (bf16)(cvtpk(o1[r], 0.f) & 0xffffu); }
}
__device__ __forceinline__ void sb_phase(Frame& F) {
    const int G = gridDim.x, bx = blockIdx.x; const int vcu = (G % 8 == 0) ? (bx % 8) * (G / 8) + bx / 8 : bx;
    const bf16 *Qs = (const bf16*)(F.ws + WS_QS), *Ks = (const bf16*)(F.ws + WS_KS), *Vs = (const bf16*)(F.ws + WS_VS); bf16* MIX = (bf16*)(F.ws + WS_MIX);
    for (int u = vcu; u < 256; u += G) { const int bh = u >> 3, s = u & 7;
        sb_unit(bh, s, Qs, Ks, Vs, MIX, F.lds + RING_OFF + 65536, F.tid);
        sb_unit(bh, 15 - s, Qs, Ks, Vs, MIX, F.lds + RING_OFF + 65536, F.tid); }
}
}

__device__ __forceinline__ void conv_phase(Frame& F, const Args& A, int l) {
    const int tid = F.tid, c = tid & 255, th = tid >> 8, lane = F.lane, wave = F.wave;
    LAS float* cbuf = (LAS float*)(F.lds + RING_OFF + 65536);
    const bf16* Hc = (const bf16*)(F.ws + WS_HC); bf16* MIX = (bf16*)(F.ws + WS_MIX);
    const float* dww = A.dw_w + (size_t)l * CK * CW; const float bias = A.dw_b[l * CW + c];
    float w[CK];
#pragma unroll
    for (int j = 0; j < CK; ++j) w[j] = dww[j * CW + c];
    const f32x4 lg = *(const f32x4*)(A.ln_g + l * CW + 4 * lane), lb = *(const f32x4*)(A.ln_b + l * CW + 4 * lane);
    for (int tile = blockIdx.x; tile < M / 64; tile += gridDim.x) {
        const int row0 = tile * 64 + 32 * th, tb = row0 % SEQ, bstart = row0 - tb;
        float acc[32];
#pragma unroll
        for (int o = 0; o < 32; ++o) acc[o] = bias;
        unsigned short hv[62];
        const bf16* hp = Hc + ((ptrdiff_t)row0 - (CK - 1)) * CW + c;
#pragma unroll
        for (int q = 0; q < 62; ++q) hv[q] = hp[q * CW];
        asm volatile("" ::: "memory");
#pragma unroll
        for (int q = 0; q < 62; ++q) {
            const bool ok = (row0 - (CK - 1) + q) >= bstart; const float x = ok ? bf2f(hv[q]) : 0.f;
#pragma unroll
            for (int o = (q > 30 ? q - 30 : 0); o <= (q < 31 ? q : 31); ++o) acc[o] += w[q - o] * x;
        }
#pragma unroll
        for (int o = 0; o < 32; ++o) cbuf[(32 * th + o) * CW + c] = acc[o];
        __syncthreads();
#pragma unroll 2
        for (int k = 0; k < 8; ++k) { const int tok = wave * 8 + k; const f32x4 v = *(const LAS f32x4*)(cbuf + tok * CW + 4 * lane);
            const float mean = wave_sum((v[0] + v[1]) + (v[2] + v[3])) * (1.0f / 256.0f); const f32x4 d = v - mean;
            const float var = wave_sum((d[0] * d[0] + d[1] * d[1]) + (d[2] * d[2] + d[3] * d[3])) * (1.0f / 256.0f); const float r = __builtin_amdgcn_rsqf(var + EPS);
            const f32x4 y = d * r * lg + lb; v2u o; o.x = pk2(y[0] * sigmoidf_(y[0]), y[1] * sigmoidf_(y[1])); o.y = pk2(y[2] * sigmoidf_(y[2]), y[3] * sigmoidf_(y[3]));
            *(v2u*)(MIX + (((size_t)((tile * 64 + tok) >> 7) * 16 + (12 + (lane >> 4))) * 8192 + ((tile * 64 + tok) & 127) * 64 + ((4 * lane) & 63))) = o; }
        __syncthreads();
    }
}

namespace ret2 {
constexpr int RET_CPG = 4, RET_NG = 64 / RET_CPG, RET_WAVES = 4;
using sba::bf16x8; using sba::s16x4; using sba::f32x16; using sba::frag8; using sba::vtr; using sba::cvtpk;
__device__ __forceinline__ bf16x8 tr2(const LAS unsigned char* p) { const s16x4 a = vtr(p), b = vtr(p + 512); return (bf16x8){a[0], a[1], a[2], a[3], b[0], b[1], b[2], b[3]}; }
#define RET_MFMA(a, b, c) __builtin_amdgcn_mfma_f32_32x32x16_bf16(a, b, c, 0, 0, 0)
__device__ __forceinline__ v4u swap32x2(v4u v) { const auto r0 = __builtin_amdgcn_permlane32_swap(v.x, v.z, false, false); const auto r1 = __builtin_amdgcn_permlane32_swap(v.y, v.w, false, false); return (v4u){r0[0], r1[0], r0[1], r1[1]}; }
__device__ __forceinline__ void stage_tiles(const bf16* Kt, const bf16* Vt, LAS unsigned char* Kimg, LAS unsigned char* Vimg, int lane) {
    v4u kx[8], vx[8];
#pragma unroll
    for (int i = 0; i < 8; ++i) { kx[i] = ((const v4u*)Kt)[lane + 64 * i]; vx[i] = ((const v4u*)Vt)[lane + 64 * i]; }
    asm volatile("" ::: "memory");
#pragma unroll
    for (int i = 0; i < 8; ++i) { const int p = lane + 64 * i, key = p >> 3, c = p & 7; const unsigned dst = (unsigned)((c >> 2) * 4096 + key * 64 + (c & 3) * 16);
        *(LAS v4u*)(Kimg + dst) = kx[i]; *(LAS v4u*)(Vimg + dst) = vx[i]; }
    asm volatile("s_waitcnt lgkmcnt(0)" ::: "memory");
}
#define RET_KV() do { _Pragma("unroll") for (int ks = 0; ks < 4; ++ks) { \
            const bf16x8 k0_ = tr2(Kimg + ks * 1024 + vlane), k1_ = tr2(Kimg + 4096 + ks * 1024 + vlane), v0_ = tr2(Vimg + ks * 1024 + vlane), v1_ = tr2(Vimg + 4096 + ks * 1024 + vlane); \
            S00 = RET_MFMA(k0_, v0_, S00); S01 = RET_MFMA(k0_, v1_, S01); S10 = RET_MFMA(k1_, v0_, S10); S11 = RET_MFMA(k1_, v1_, S11); } \
        _Pragma("unroll") for (int r = 0; r < 16; ++r) { S00[r] *= g64; S01[r] *= g64; S10[r] *= g64; S11[r] *= g64; } } while (0)
__device__ __forceinline__ void ret_m1(int bh, int g, const Args& A, unsigned char* ws, LAS unsigned char* wlds, int lane) {
    const int hi = lane >> 5, hh = bh & 7; const float lg2 = A.ret_lg2[hh], g64 = __builtin_amdgcn_exp2f(64.f * lg2);
    const size_t hb = (size_t)bh * SEQ * HD; const bf16 *Rk = (const bf16*)(ws + WS_RK) + hb, *Rv = (const bf16*)(ws + WS_RV) + hb;
    LAS unsigned char* Kimg = wlds; LAS unsigned char* Vimg = wlds + 8192;
    const unsigned vlane = (unsigned)(((lane >> 4) & 1) * 32 + (lane & 3) * 8 + (4 * hi + ((lane & 15) >> 2)) * 64);
    f32x16 S00, S01, S10, S11;
#pragma unroll
    for (int r = 0; r < 16; ++r) { S00[r] = 0.f; S01[r] = 0.f; S10[r] = 0.f; S11[r] = 0.f; }
    for (int s = 0; s < RET_CPG; ++s) { const int n = RET_CPG * g + s;
        stage_tiles(Rk + (size_t)n * 64 * HD, Rv + (size_t)n * 64 * HD, Kimg, Vimg, lane);
        RET_KV(); }
    float* T = (float*)(ws + WS_RT) + (size_t)(bh * RET_NG + g) * 4096 + lane;
#pragma unroll
    for (int r = 0; r < 16; ++r) { T[(0 * 16 + r) * 64] = S00[r]; T[(1 * 16 + r) * 64] = S01[r]; T[(2 * 16 + r) * 64] = S10[r]; T[(3 * 16 + r) * 64] = S11[r]; }
    asm volatile("s_waitcnt vmcnt(0)" ::: "memory");
}
__device__ __forceinline__ void ret_m3(int bh, int g, int part, const Args& A, int l, unsigned char* ws, LAS unsigned char* wlds, int lane) {
    const int r32 = lane & 31, hi = lane >> 5, b = bh >> 3, hh = bh & 7; const float lg2 = A.ret_lg2[hh], g64 = __builtin_amdgcn_exp2f(64.f * lg2), g512 = __builtin_amdgcn_exp2f((float)(64 * RET_CPG) * lg2);
    const size_t hb = (size_t)bh * SEQ * HD;
    const bf16 *Rq = (const bf16*)(ws + WS_RQ) + hb, *Rk = (const bf16*)(ws + WS_RK) + hb, *Rv = (const bf16*)(ws + WS_RV) + hb, *Rg = (const bf16*)(ws + WS_RG); bf16* MIX = (bf16*)(ws + WS_MIX);
    LAS unsigned char* Kimg = wlds; LAS unsigned char* Vimg = wlds + 8192;
    const unsigned vlane = (unsigned)(((lane >> 4) & 1) * 32 + (lane & 3) * 8 + (4 * hi + ((lane & 15) >> 2)) * 64);
    f32x16 S00, S01, S10, S11;
#pragma unroll
    for (int r = 0; r < 16; ++r) { S00[r] = 0.f; S01[r] = 0.f; S10[r] = 0.f; S11[r] = 0.f; }
    {
        const int q = g >> 2, nsteps = q + (g & 3); const float g1024 = __builtin_amdgcn_exp2f(1024.f * lg2);
        const float* Qb = (const float*)(ws + WS_RQT) + (size_t)(bh * 4) * 4096 + lane; const float* Tb = (const float*)(ws + WS_RT) + (size_t)(bh * RET_NG + 4 * q) * 4096 + lane;
        if (nsteps > 0) {
            const float* p0 = q > 0 ? Qb : Tb; f32x16 t0, t1, t2, t3;
#pragma unroll
            for (int r = 0; r < 16; ++r) { t0[r] = p0[(0 * 16 + r) * 64]; t1[r] = p0[(1 * 16 + r) * 64]; t2[r] = p0[(2 * 16 + r) * 64]; t3[r] = p0[(3 * 16 + r) * 64]; }
            for (int k = 0; k < nsteps; ++k) { f32x16 n0 = t0, n1 = t1, n2 = t2, n3 = t3; const float fac = k < q ? g1024 : g512;
                if (k + 1 < nsteps) { const float* pn = (k + 1 < q) ? Qb + (size_t)(k + 1) * 4096 : Tb + (size_t)(k + 1 - q) * 4096;
#pragma unroll
                    for (int r = 0; r < 16; ++r) { n0[r] = pn[(0 * 16 + r) * 64]; n1[r] = pn[(1 * 16 + r) * 64]; n2[r] = pn[(2 * 16 + r) * 64]; n3[r] = pn[(3 * 16 + r) * 64]; } }
#pragma unroll
                for (int r = 0; r < 16; ++r) { S00[r] = S00[r] * fac + t0[r]; S01[r] = S01[r] * fac + t1[r]; S10[r] = S10[r] * fac + t2[r]; S11[r] = S11[r] * fac + t3[r]; }
                t0 = n0; t1 = n1; t2 = n2; t3 = n3; } } }
    if (part == 1) { for (int s = 0; s < RET_CPG / 2; ++s) { const int n = RET_CPG * g + s;
            stage_tiles(Rk + (size_t)n * 64 * HD, Rv + (size_t)n * 64 * HD, Kimg, Vimg, lane); RET_KV(); } }
    const float* gnp = A.ret_g + l * RW + hh * HD + 4 * hi;
    for (int s = (part == 1) ? RET_CPG / 2 : 0; s < ((part == 0) ? RET_CPG / 2 : RET_CPG); ++s) {
        const int n = RET_CPG * g + s, t0 = 64 * n;
        stage_tiles(Rk + (size_t)n * 64 * HD, Rv + (size_t)n * 64 * HD, Kimg, Vimg, lane);
#pragma unroll
        for (int ih = 0; ih < 2; ++ih) {
            const bf16* qrow = Rq + (size_t)(t0 + 32 * ih + r32) * HD; const size_t orow = (size_t)b * SEQ + t0 + 32 * ih + r32;
            v4u gate16[2][2];
#pragma unroll
            for (int eh = 0; eh < 2; ++eh)
#pragma unroll
                for (int pq = 0; pq < 2; ++pq) gate16[eh][pq] = *(const v4u*)(Rg + orow * RW + hh * HD + 32 * eh + 16 * pq + 8 * hi);
            bf16x8 qf[4];
#pragma unroll
            for (int d0 = 0; d0 < 4; ++d0) qf[d0] = *(const bf16x8*)(qrow + 16 * d0 + 8 * hi);
            f32x16 p, z0, z1;
#pragma unroll
            for (int r = 0; r < 16; ++r) { p[r] = 0.f; z0[r] = 0.f; z1[r] = 0.f; }
#pragma unroll
            for (int d0 = 0; d0 < 4; ++d0) { const bf16x8 kf = *(const LAS bf16x8*)(Kimg + (d0 >> 1) * 4096 + r32 * 64 + (d0 & 1) * 32 + hi * 16); p = RET_MFMA(kf, qf[d0], p); }
            if (ih == 0) {
#pragma unroll
                for (int r = 0; r < 16; ++r) { const int j = (r & 3) + 8 * (r >> 2) + 4 * hi; if (j > r32) p[r] = 0.f; }
            }
#pragma unroll
            for (int ks = 0; ks < 2; ++ks) { const bf16x8 pf = frag8(p, ks), v0 = tr2(Vimg + ks * 1024 + vlane), v1 = tr2(Vimg + 4096 + ks * 1024 + vlane); z0 = RET_MFMA(v0, pf, z0); z1 = RET_MFMA(v1, pf, z1); }
            if (ih == 1) {
#pragma unroll
                for (int r = 0; r < 16; ++r) p[r] = 0.f;
#pragma unroll
                for (int d0 = 0; d0 < 4; ++d0) { const bf16x8 kf = *(const LAS bf16x8*)(Kimg + (d0 >> 1) * 4096 + (32 + r32) * 64 + (d0 & 1) * 32 + hi * 16); p = RET_MFMA(kf, qf[d0], p); }
#pragma unroll
                for (int r = 0; r < 16; ++r) { const int j = (r & 3) + 8 * (r >> 2) + 4 * hi; if (j > r32) p[r] = 0.f; }
#pragma unroll
                for (int ks = 0; ks < 2; ++ks) { const bf16x8 pf = frag8(p, ks), v0 = tr2(Vimg + (2 + ks) * 1024 + vlane), v1 = tr2(Vimg + 4096 + (2 + ks) * 1024 + vlane); z0 = RET_MFMA(v0, pf, z0); z1 = RET_MFMA(v1, pf, z1); }
            }
#pragma unroll
            for (int ks = 0; ks < 4; ++ks) { const v4u qx = swap32x2(__builtin_bit_cast(v4u, qf[ks]));
                const bf16x8 qa = __builtin_bit_cast(bf16x8, (v4u){qx.x, qx.y, qx.z, qx.w});
                const bf16x8 s0 = (ks < 2) ? frag8(S00, ks & 1) : frag8(S10, ks & 1), s1 = (ks < 2) ? frag8(S01, ks & 1) : frag8(S11, ks & 1);
                z0 = RET_MFMA(s0, qa, z0); z1 = RET_MFMA(s1, qa, z1); }
            const float gi = __builtin_amdgcn_exp2f((float)(32 * ih + r32) * lg2); float ss = 0.f;
#pragma unroll
            for (int r = 0; r < 16; ++r) { z0[r] *= gi; z1[r] *= gi; ss += z0[r] * z0[r] + z1[r] * z1[r]; }
            ss += __shfl_xor(ss, 32);
            const float rn = __builtin_amdgcn_rsqf(ss * (1.0f / 64.0f) + EPS);
            bf16* dst = MIX + (((size_t)(((int)orow) >> 7) * 16 + (4 + hh)) * 8192 + (((int)orow) & 127) * 64 + (8 * hi));
#pragma unroll
            for (int eh = 0; eh < 2; ++eh)
#pragma unroll
                for (int pq = 0; pq < 2; ++pq) { const v4u g4 = swap32x2(gate16[eh][pq]);
                    v4u o;
#pragma unroll
                    for (int qq = 0; qq < 2; ++qq) { const int q = 2 * pq + qq; const unsigned gx = qq ? g4.z : g4.x, gy = qq ? g4.w : g4.y; const f32x4 gq = *(const f32x4*)(gnp + 32 * eh + 8 * q);
                        const float y0 = (eh ? z1 : z0)[4 * q + 0] * rn * gq[0] * bflo(gx), y1 = (eh ? z1 : z0)[4 * q + 1] * rn * gq[1] * bfhi(gx);
                        const float y2 = (eh ? z1 : z0)[4 * q + 2] * rn * gq[2] * bflo(gy), y3 = (eh ? z1 : z0)[4 * q + 3] * rn * gq[3] * bfhi(gy);
                        if (qq) { o.z = cvtpk(y0, y1); o.w = cvtpk(y2, y3); } else { o.x = cvtpk(y0, y1); o.y = cvtpk(y2, y3); } }
                    *(v4u*)(dst + 32 * eh + 16 * pq) = swap32x2(o); }
        }
        RET_KV();
    }
}
#undef RET_KV
#undef RET_MFMA
__device__ __forceinline__ void ret_pass(Frame& F, const Args& A, int l, bool m3) {
#ifndef RET_M3_SPLIT
#define RET_M3_SPLIT 1
#endif
    if (m3 && RET_M3_SPLIT) {
        for (int it = blockIdx.x * NWAVES + F.wave; it < BATCH * RH * RET_NG * 2; it += gridDim.x * NWAVES)
            ret_m3((it >> 1) / RET_NG, (it >> 1) % RET_NG, it & 1, A, l, F.ws, F.lds + RING_OFF + F.wave * 16384, F.lane);
        return; }
    if (m3) { if (F.wave >= RET_WAVES) return;
        for (int it = blockIdx.x * RET_WAVES + F.wave; it < BATCH * RH * RET_NG; it += gridDim.x * RET_WAVES) ret_m3(it / RET_NG, it % RET_NG, 2, A, l, F.ws, F.lds + RING_OFF + F.wave * 16384, F.lane);
        return; }
    if (F.wave >= RET_WAVES) return;
    for (int it = blockIdx.x * RET_WAVES + F.wave; it < BATCH * RH * RET_NG; it += gridDim.x * RET_WAVES)
        ret_m1(it / RET_NG, it % RET_NG, A, F.ws, F.lds + RING_OFF + F.wave * 16384, F.lane);
}
__device__ __forceinline__ void quarter_combine(Frame& F, const Args& A) {
    if (F.wave >= RET_WAVES) return;
    for (int c = blockIdx.x; c < BATCH * RH * 4; c += gridDim.x) { const int bh = c >> 2; const float g256 = __builtin_amdgcn_exp2f((float)(64 * RET_CPG) * A.ret_lg2[bh & 7]);
        const float* T = (const float*)(F.ws + WS_RT) + (size_t)(c * 4) * 4096 + (F.wave * 16) * 64 + F.lane; float* Q = (float*)(F.ws + WS_RQT) + (size_t)c * 4096 + (F.wave * 16) * 64 + F.lane;
        float acc[16];
#pragma unroll
        for (int r = 0; r < 16; ++r) acc[r] = T[r * 64];
#pragma unroll
        for (int i = 1; i < 4; ++i) {
#pragma unroll
            for (int r = 0; r < 16; ++r) acc[r] = acc[r] * g256 + T[(size_t)i * 4096 + r * 64]; }
#pragma unroll
        for (int r = 0; r < 16; ++r) __hip_atomic_store(Q + r * 64, acc[r], __ATOMIC_RELAXED, __HIP_MEMORY_SCOPE_AGENT);
    }
    asm volatile("s_waitcnt vmcnt(0)" ::: "memory");
}
__device__ __forceinline__ void quarter_publish(unsigned* flags, int tid) {
    __syncthreads();
    if (tid == 0) __hip_atomic_store(flags + blockIdx.x, 1u, __ATOMIC_RELAXED, __HIP_MEMORY_SCOPE_AGENT);
}
__device__ __forceinline__ void quarter_wait(unsigned* flags, int tid) {
    const int c = (int)blockIdx.x, q = c & 3;
    if (tid == 0 && q > 0) {
        for (int k = 0; k < q; ++k) while (__hip_atomic_load(flags + (c & ~3) + k, __ATOMIC_RELAXED, __HIP_MEMORY_SCOPE_AGENT) == 0u) __builtin_amdgcn_s_sleep(2);
        __builtin_amdgcn_fence(__ATOMIC_ACQUIRE, "agent");
        asm volatile("s_waitcnt vmcnt(0)" ::: "memory");
    }
    __syncthreads();
}
}

constexpr int PH_PER_LAYER = 5, N_PHASES = 1 + DEPTH * PH_PER_LAYER;
constexpr int CW_QFLAG = 1024;
__global__ void __launch_bounds__(NWAVES * 64, 2) mk_fwd(Args args) {
    extern __shared__ __attribute__((aligned(16))) unsigned char lds[];
    Frame F;
    F.lds = (LAS unsigned char*)lds; F.tid = threadIdx.x; F.lane = F.tid & 63; F.wave = __builtin_amdgcn_readfirstlane(F.tid >> 6); F.gw = blockIdx.x * NWAVES + F.wave; F.ws = args.ws;
#if MK_ONE_LAUNCH
    cg::grid_group grid = cg::this_grid();
    for (int u = threadIdx.x; u < (LDS_BYTES - LDSCTL_OFF) / 4; u += NWAVES * 64) ((LAS unsigned*)(F.lds + LDSCTL_OFF))[u] = 0u;
    __syncthreads();
    XcdBarrier bar = xcd_barrier_post((unsigned*)(args.ws + WS_CTL) + CW_BAR, (volatile LAS unsigned*)(F.lds + MISC_OFF) + 8);
#endif
    for (int ph = args.ph_lo; ph < args.ph_hi; ++ph) {
        { int t_ = threadIdx.x; asm volatile("" : "+v"(t_)); F.tid = t_; F.lane = t_ & 63; F.wave = __builtin_amdgcn_readfirstlane(t_ >> 6); F.gw = blockIdx.x * NWAVES + F.wave; }
#ifdef PROBE_KIND
#ifndef PROBE_REPS
#define PROBE_REPS 1
#endif
        const int pp = ph > PROBE_KIND + PROBE_REPS ? ph - PROBE_REPS : (ph > PROBE_KIND ? PROBE_KIND : ph);
#else
        const int pp = ph;
#endif
        const int l = pp == 0 ? 0 : (pp - 1) / PH_PER_LAYER, kind = pp == 0 ? 0 : ((pp - 1) % PH_PER_LAYER) + 1;
        unsigned char* wl = F.ws + WS_W + (size_t)l * W_LAYER;
        if (kind == 0) p0_prologue(F, args);
        else if (kind == 1) {
            pg8::Gemm g{(const pg8::bf16_t*)(F.ws + WS_XNG), (const pg8::bf16_t*)(wl + W_IN), M, INC, DM, 1}; pg8::StaticOrder S; S.init(M, INC, gridDim.x, (int)blockIdx.x);
            pg8::fill_rs(F.lds, S, (const float*)(F.ws + WS_SSQ));
            pg8::EpiInProj E{F.lds, F.ws, args.sbq_g + l * HD, args.sbk_g + l * HD, args.pw_b + l * 2 * CW, WS_QS, WS_KS, WS_VS, WS_RQ, WS_RK, WS_RV, WS_RG, WS_HC, 0, SB_C2, EPS};
            pg8::gemm_phase<pg8::EpiInProj, pg8::StaticOrder, PG8_ALIGN, PG8_SP2>(F.lds + RING_OFF, g, S, E);
            if (l == 0 && blockIdx.x >= 128) convert_weights(F, args, 1, DEPTH, ((int)blockIdx.x - 128) * NWAVES + F.wave, ((int)gridDim.x - 128) * NWAVES);
        }
        else if (kind == 2) { unsigned* qf = (unsigned*)(F.ws + WS_CTL) + CW_QFLAG + l * 256;
            ret2::ret_pass(F, args, l, false); conv_phase(F, args, l); ret2::quarter_combine(F, args); ret2::quarter_publish(qf, F.tid); sba::sb_phase(F); ret2::quarter_wait(qf, F.tid); ret2::ret_pass(F, args, l, true); }
        else if (kind == 4) {
            pg8::Gemm g{(const pg8::bf16_t*)(F.ws + WS_XNG), (const pg8::bf16_t*)(wl + W_1), M, DFF, DM, 1}; pg8::StaticOrder S; S.init(M, DFF, gridDim.x, (int)blockIdx.x);
            pg8::fill_rs(F.lds, S, (const float*)(F.ws + WS_SSQ));
            pg8::EpiScaleBf16 E{(pg8::bf16_t*)(F.ws + WS_F), DFF, F.lds, 1};
            pg8::gemm_phase<pg8::EpiScaleBf16, pg8::StaticOrder, PG8_ALIGN, PG8_SP2>(F.lds + RING_OFF, g, S, E);
        }
        else {
            const bool ff = kind == 5; const bool last = ff && (l + 1 == DEPTH);
            pg8::Gemm g{(const pg8::bf16_t*)(F.ws + (ff ? WS_F : WS_MIX)), (const pg8::bf16_t*)(wl + (ff ? W_2 : W_OUT)), M, DM, ff ? DFF : DM, 1}; pg8::StaticOrder S; S.init(M, DM, gridDim.x, (int)blockIdx.x);
            pg8::EpiResid E{(pg8::bf16_t*)(F.ws + WS_XNG), last ? args.out : nullptr, (float*)(F.ws + WS_SSQ)};
            pg8::gemm_phase<pg8::EpiResid, pg8::StaticOrder, PG8_ALIGN, PG8_SP2>(F.lds + RING_OFF, g, S, E);
        }
#if MK_ONE_LAUNCH
        if (ph + 1 < args.ph_hi) { if (args.ph_hi > 4096) grid.sync(); xcd_barrier(bar); }
#endif
    }
}

extern "C" void kernel_launch(void* const* d_in, const int* in_sizes, int n_in, void* d_out, int out_size, void* d_ws, size_t ws_size, hipStream_t stream) {
    static int grid = 0;
    if (grid == 0) {
        if (n_in != 15 || in_sizes[0] != M * DM || out_size != M * DM || ws_size < WS_END) { fprintf(stderr, "kernel_launch: unexpected shapes (n_in %d, in0 %d, out %d, ws %zu); nothing launched\n", n_in, n_in > 0 ? in_sizes[0] : -1, out_size, ws_size); grid = -1; return; }
        int dev = 0, cus = 0, per_cu = 0;
        if (hipGetDevice(&dev) != hipSuccess || hipDeviceGetAttribute(&cus, hipDeviceAttributeMultiprocessorCount, dev) != hipSuccess) { grid = -1; return; }
        if (hipFuncSetAttribute((const void*)mk_fwd, hipFuncAttributeMaxDynamicSharedMemorySize, LDS_BYTES) != hipSuccess) { fprintf(stderr, "kernel_launch: hipFuncSetAttribute failed\n"); grid = -1; return; }
        if (hipOccupancyMaxActiveBlocksPerMultiprocessor(&per_cu, (const void*)mk_fwd, NWAVES * 64, LDS_BYTES) != hipSuccess || per_cu < 1) { fprintf(stderr, "kernel_launch: occupancy query says %d blocks per CU\n", per_cu); per_cu = 1; }
        (void)hipGetLastError();
        if (cus < 256) { fprintf(stderr, "kernel_launch: built for a 256-CU device (unit lists and LDS tables are sized for 256 workgroups); found %d CUs; nothing launched\n", cus); grid = -1; return; }
        grid = 256;
    }
    if (grid < 0) return;
    (void)hipMemsetAsync((char*)d_ws + WS_CTL, 0, CTL_ZERO_BYTES, stream);
    Args a{};
    a.x = (const float*)d_in[0]; a.mix_g = (const float*)d_in[1]; a.w_in = (const float*)d_in[2]; a.sbq_g = (const float*)d_in[3]; a.sbk_g = (const float*)d_in[4]; a.ret_g = (const float*)d_in[5];
    a.pw_b = (const float*)d_in[6]; a.dw_w = (const float*)d_in[7]; a.dw_b = (const float*)d_in[8]; a.ln_g = (const float*)d_in[9]; a.ln_b = (const float*)d_in[10]; a.w_out = (const float*)d_in[11];
    a.mlp_g = (const float*)d_in[12]; a.w_ff1 = (const float*)d_in[13]; a.w_ff2 = (const float*)d_in[14];
    a.out = (float*)d_out; a.ws = (unsigned char*)d_ws;
    for (int h = 0; h < 8; ++h) a.ret_lg2[h] = (float)log2(1.0 - exp2(-5.0 - (double)h));
#if MK_ONE_LAUNCH
#ifdef PROBE_KIND
    a.ph_lo = 0; a.ph_hi = N_PHASES + PROBE_REPS;
#else
    a.ph_lo = 0; a.ph_hi = N_PHASES;
#endif
    void* kargs[] = {&a};
    hipError_t e = hipLaunchCooperativeKernel((const void*)mk_fwd, dim3(grid), dim3(NWAVES * 64), kargs, LDS_BYTES, stream);
    if (e != hipSuccess) fprintf(stderr, "kernel_launch: cooperative launch failed: %s (grid %d)\n", hipGetErrorString(e), grid);
#else
    for (int p = 0; p < N_PHASES; ++p) { a.ph_lo = p; a.ph_hi = p + 1; hipLaunchKernelGGL(mk_fwd, dim3(grid), dim3(NWAVES * 64), LDS_BYTES, stream, a); }
#endif
}
```

```cpp
#include <hip/hip_runtime.h>
#include <hip/hip_cooperative_groups.h>
#include <cstdio>
#include <cstdint>
#include <cmath>
namespace cg = cooperative_groups;

#ifndef MK_ONE_LAUNCH
#define MK_ONE_LAUNCH 1
#endif
namespace pg8 {
#define PG8_LAS __attribute__((address_space(3)))
typedef unsigned short bf16_t;
typedef short bf16x8 __attribute__((ext_vector_type(8)));
typedef float f32x4 __attribute__((ext_vector_type(4)));
typedef unsigned u32x4 __attribute__((ext_vector_type(4)));
constexpr int BM = 256, BK = 64, HALF = 128, HTB = HALF * BK * 2  , STAGE_BYTES = 8 * HTB, NXCD = 8, WGM = 8;

__host__ __device__ __forceinline__ int lds_byte(int r, int c) { const int st = (r >> 4) * 2 + (c >> 5), rr = r & 15, cc = c & 31, ob = rr * 64 + cc * 2; return st * 1024 + (ob ^ (((ob >> 9) & 1) << 5)); }
__host__ __device__ __forceinline__ void stage_rc(int b, int& R, int& C) { const int st = b / 1024, sb = b % 1024, swz = sb ^ (((sb >> 9) & 1) << 5); R = (st >> 1) * 16 + swz / 64; C = (st & 1) * 32 + (swz % 64) / 2; }
__host__ __device__ __forceinline__ int perm32(int rho) { const int n = rho >> 4, i = rho & 15; return 8 * (i >> 2) + 4 * n + (i & 3); }

struct Unit { int pm, pn, idx; };
struct Gemm { const bf16_t* A; const bf16_t* Bt; int M, N, K; int a_blocked; };

struct StaticOrder {
    int nM, nN, nwg, G, c;
    __host__ __device__ void init(int M, int N, int G_, int c_) { nM = M / BM; nN = N / BM; nwg = nM * nN; G = G_; c = c_; }
    __host__ __device__ bool next(int i, Unit& u) const {
        const long L = (long)i * G + c; if (L >= nwg) return false;
        int wgid = (int)L; { const int q = nwg / NXCD, r = nwg % NXCD, xcd = wgid % NXCD, off = wgid / NXCD; wgid = (xcd < r ? xcd * (q + 1) : r * (q + 1) + (xcd - r) * q) + off; }
        const int nig = WGM * nN, gid = wgid / nig, fm = gid * WGM, gsz = (nM - fm) < WGM ? (nM - fm) : WGM;
        u.pm = fm + ((wgid % nig) % gsz); u.pn = (wgid % nig) / gsz; u.idx = i; return true;
    }
    __device__ __forceinline__ void a_ready(const Unit&) const {}
    __device__ __forceinline__ void done(const Unit&) const {}
};

typedef float f32x2c_t __attribute__((ext_vector_type(2))); typedef __bf16 bf16x2c_t __attribute__((ext_vector_type(2)));
__device__ __forceinline__ unsigned cvt_pk_bf16(float lo, float hi) { const f32x2c_t v = {lo, hi}; const bf16x2c_t b = __builtin_convertvector(v, bf16x2c_t); return __builtin_bit_cast(unsigned, b); }
typedef float f32x2 __attribute__((ext_vector_type(2)));
constexpr float RMS_EPS = 1e-6f;
template <int CTRL> __device__ __forceinline__ float quad_dpp(float v) { return __int_as_float(__builtin_amdgcn_update_dpp(0, __float_as_int(v), CTRL, 0xF, 0xF, true)); }
__device__ __forceinline__ float xor16_sum(float v) { const auto r = __builtin_amdgcn_permlane16_swap(__float_as_uint(v), __float_as_uint(v), false, false); return __uint_as_float(r[0]) + __uint_as_float(r[1]); }
__device__ __forceinline__ float xor32_sum(float v) { const auto r = __builtin_amdgcn_permlane32_swap(__float_as_uint(v), __float_as_uint(v), false, false); return __uint_as_float(r[0]) + __uint_as_float(r[1]); }
constexpr int RS_OFF = 131072 + 1024;
template <class Sched> __device__ __forceinline__ void fill_rs(PG8_LAS unsigned char* lds0, const Sched& S, const float* ssq) {
    PG8_LAS float* rsl = (PG8_LAS float*)(lds0 + RS_OFF); Unit u;
#pragma unroll 1
    for (int i = 0; i < 8 && S.next(i, u); ++i) { int t = threadIdx.x; asm volatile("" : "+v"(t));
#pragma unroll
        for (int j = 0; j < 2; ++j) { const int ch = j * 512 + t, row = ch >> 2; const f32x4 a = *(const f32x4*)(ssq + (size_t)(u.pm * BM) * 16 + (size_t)ch * 4);
            float s = (a[0] + a[1]) + (a[2] + a[3]); s += quad_dpp<0xB1>(s); s += quad_dpp<0x4E>(s);
            if ((ch & 3) == 0) rsl[i * 256 + row] = __builtin_amdgcn_rsqf(s * (1.0f / 1024.0f) + RMS_EPS); } }
    __syncthreads();
}
#define PG8_ROW_RS(lds0_, u_, row_) (((const PG8_LAS float*)((lds0_) + RS_OFF))[(u_).idx * 256 + ((row_) & 255)])
__device__ __forceinline__ u32x4 pair_swap(u32x4 x) { u32x4 y;
    y.x = (unsigned)__builtin_amdgcn_mov_dpp((int)x.x, 0xB1, 0xF, 0xF, true); y.y = (unsigned)__builtin_amdgcn_mov_dpp((int)x.y, 0xB1, 0xF, 0xF, true);
    y.z = (unsigned)__builtin_amdgcn_mov_dpp((int)x.z, 0xB1, 0xF, 0xF, true); y.w = (unsigned)__builtin_amdgcn_mov_dpp((int)x.w, 0xB1, 0xF, 0xF, true); return y; }
#define PG8_FULL_LINE(w0_, w1_, odd_, sa_, sb_) do { const u32x4 snd_ = (odd_) ? (w0_) : (w1_); const u32x4 rcv_ = pair_swap(snd_); sa_ = (odd_) ? rcv_ : (w0_); sb_ = (odd_) ? (w1_) : rcv_; } while (0)
__device__ __forceinline__ __amdgpu_buffer_rsrc_t wt_rsrc(void* base, unsigned bytes) { return __builtin_amdgcn_make_buffer_rsrc(base, 0, bytes, 0x00020000); }
__device__ __forceinline__ void st16_wt(__amdgpu_buffer_rsrc_t r, unsigned byteoff, u32x4 v) { __builtin_amdgcn_raw_buffer_store_b128(v, r, byteoff, 0,   16); }
struct EpiScaleBf16 {
    static constexpr bool PERM = true, AFTER_DRAIN = false;
    bf16_t* O; int ldc; PG8_LAS unsigned char* lds0; int ACT;
    __device__ __forceinline__ void operator()(const f32x4 (&acc)[2][2][4][2], const Unit& u, int wr, int wc, int fr, int fq) const {
        const int row0 = u.pm * BM + wr * 64 + fr; const int odd = fr & 1;
        const __amdgpu_buffer_rsrc_t orr = wt_rsrc(O, (unsigned)(32768u * (unsigned)ldc * 2u));
#pragma unroll
        for (int ai = 0; ai < 2; ++ai)
#pragma unroll
            for (int m = 0; m < 4; ++m) { const int row = row0 + ai * HALF + m * 16; const float rs = PG8_ROW_RS(lds0, u, row);
                const unsigned P = (((unsigned)(row >> 7) * (unsigned)(ldc >> 6) + (unsigned)(u.pn * 4 + wc)) * 8192u + (unsigned)(((row - odd) & 127) * 64 + 8 * fq + odd * 32)) * 2u;
                u32x4 w[2];
#pragma unroll
                for (int bj = 0; bj < 2; ++bj) { f32x4 v0 = acc[ai][bj][m][0] * rs, v1 = acc[ai][bj][m][1] * rs;
                    if (ACT == 1) {
#pragma unroll
                        for (int j = 0; j < 4; ++j) { const float a = fmaxf(v0[j], 0.f), b = fmaxf(v1[j], 0.f); v0[j] = a * a; v1[j] = b * b; } }
                    w[bj].x = cvt_pk_bf16(v0[0], v0[1]); w[bj].y = cvt_pk_bf16(v0[2], v0[3]); w[bj].z = cvt_pk_bf16(v1[0], v1[1]); w[bj].w = cvt_pk_bf16(v1[2], v1[3]); }
                u32x4 sa, sb; PG8_FULL_LINE(w[0], w[1], odd, sa, sb);
                __builtin_nontemporal_store(sa, (u32x4*)((char*)O + P)); __builtin_nontemporal_store(sb, (u32x4*)((char*)O + P + 128u)); }
    }
};
struct EpiResid {
    static constexpr bool PERM = true, AFTER_DRAIN = false;
    bf16_t* xb; float* out32; float* ssq;
    __device__ __forceinline__ void operator()(const f32x4 (&acc)[2][2][4][2], const Unit& u, int wr, int wc, int fr, int fq) const {
        const int row0 = u.pm * BM + wr * 64 + fr, col0 = u.pn * BM + wc * 64 + 8 * fq;
        const int odd = fr & 1;
#define PG8_XBOFF(row_, col_) ((size_t)(((row_) >> 7) * 16 + ((col_) >> 6)) * 8192 + ((row_) & 127) * 64 + ((col_) & 63))
#define PG8_XUNPACK(r_, x0_, x1_) \
        f32x4 x0_ = (f32x4){__uint_as_float(r_.x << 16), __uint_as_float(r_.x & 0xffff0000u), __uint_as_float(r_.y << 16), __uint_as_float(r_.y & 0xffff0000u)}; \
        f32x4 x1_ = (f32x4){__uint_as_float(r_.z << 16), __uint_as_float(r_.z & 0xffff0000u), __uint_as_float(r_.w << 16), __uint_as_float(r_.w & 0xffff0000u)};
        if (out32 == nullptr) {
#pragma unroll
            for (int ai = 0; ai < 2; ++ai) {
                u32x4 xr[4][2];
#pragma unroll
                for (int m = 0; m < 4; ++m)
#pragma unroll
                    for (int bj = 0; bj < 2; ++bj) xr[m][bj] = *(const u32x4*)(xb + PG8_XBOFF(row0 - odd + bj + ai * HALF + m * 16, col0 + odd * 32));
#pragma unroll
                for (int m = 0; m < 4; ++m) { const int row = row0 + ai * HALF + m * 16; const size_t off = (size_t)row * 1024 + col0; float sq = 0.f;
                    u32x4 xo[2], w[2]; PG8_FULL_LINE(xr[m][0], xr[m][1], odd, xo[0], xo[1]);
#pragma unroll
                    for (int bj = 0; bj < 2; ++bj) { const u32x4 r = xo[bj]; PG8_XUNPACK(r, x0, x1)
                        x0 = x0 + acc[ai][bj][m][0]; x1 = x1 + acc[ai][bj][m][1];
                        sq += ((x0[0] * x0[0] + x0[1] * x0[1]) + (x0[2] * x0[2] + x0[3] * x0[3])) + ((x1[0] * x1[0] + x1[1] * x1[1]) + (x1[2] * x1[2] + x1[3] * x1[3]));
                        w[bj].x = cvt_pk_bf16(x0[0], x0[1]); w[bj].y = cvt_pk_bf16(x0[2], x0[3]); w[bj].z = cvt_pk_bf16(x1[0], x1[1]); w[bj].w = cvt_pk_bf16(x1[2], x1[3]); }
                    { u32x4 sa, sb; PG8_FULL_LINE(w[0], w[1], odd, sa, sb); bf16_t* P = xb + PG8_XBOFF(row - odd, col0 + odd * 32); *(u32x4*)P = sa; *(u32x4*)(P + 64) = sb; }
                    sq = xor32_sum(xor16_sum(sq)); if (fq == 0) ssq[(size_t)row * 16 + u.pn * 4 + wc] = sq; }
                asm volatile("" ::: "memory"); }
        } else {
#pragma unroll
            for (int ai = 0; ai < 2; ++ai) {
                u32x4 xr[4][2];
#pragma unroll
                for (int m = 0; m < 4; ++m)
#pragma unroll
                    for (int bj = 0; bj < 2; ++bj) xr[m][bj] = *(const u32x4*)(xb + PG8_XBOFF(row0 - odd + bj + ai * HALF + m * 16, col0 + odd * 32));
#pragma unroll
                for (int m = 0; m < 4; ++m) { const size_t off = (size_t)(row0 + ai * HALF + m * 16) * 1024 + col0; u32x4 xo[2]; PG8_FULL_LINE(xr[m][0], xr[m][1], odd, xo[0], xo[1]);
#pragma unroll
                    for (int bj = 0; bj < 2; ++bj) { const u32x4 r = xo[bj]; PG8_XUNPACK(r, x0, x1)
                        x0 = x0 + acc[ai][bj][m][0]; x1 = x1 + acc[ai][bj][m][1];
                        *(f32x4*)(out32 + off + bj * 32) = x0; *(f32x4*)(out32 + off + bj * 32 + 4) = x1; } }
                asm volatile("" ::: "memory"); }
        }
#undef PG8_XUNPACK
#undef PG8_XBOFF
    }
};

__host__ __device__ __forceinline__ int inproj_srccol(int rho) {
    const int gi = rho >> 5, tile = gi >> 3, w8 = gi & 7, wc = w8 >> 1, bj = w8 & 1;
    if (tile == 11 || tile == 12) return (bj ? 3072 : 2816) + 128 * (tile - 11) + 32 * wc;
    return rho;
}
struct EpiInProj {
    static constexpr bool PERM = true, AFTER_DRAIN = false;
    PG8_LAS unsigned char* lds0; unsigned char* ws; const float* gq; const float* gk; const float* pwb; const float* retg;
    size_t oQS, oKS, oVS, oRQ, oRK, oRV, oRG, oHC, oROT; float c2, eps;
    __device__ __forceinline__ void operator()(const f32x4 (&acc)[2][2][4][2], const Unit& u, int wr, int wc, int fr, int fq_in) const {
        int fq = fq_in; asm volatile("" : "+v"(fq));
        const int pn = u.pn, rowb = u.pm * BM + wr * 64 + fr;
        f32x4 cv[2][2];
#pragma unroll
        for (int bj = 0; bj < 2; ++bj)
#pragma unroll
            for (int n = 0; n < 2; ++n) cv[bj][n] = (f32x4){0.f, 0.f, 0.f, 0.f};
        if (pn < 2) { const float* g = pn ? gk : gq;
#pragma unroll
            for (int bj = 0; bj < 2; ++bj)
#pragma unroll
                for (int n = 0; n < 2; ++n) cv[bj][n] = *(const f32x4*)(g + 32 * bj + 8 * fq + 4 * n); }
        else if (pn >= 11) {
#pragma unroll
            for (int bj = 0; bj < 2; ++bj)
#pragma unroll
                for (int n = 0; n < 2; ++n) cv[bj][n] = *(const f32x4*)(pwb + 256 * bj + 128 * (pn - 11) + 32 * wc + 8 * fq + 4 * n); }
        else if (pn >= 9) {
#pragma unroll
            for (int bj = 0; bj < 2; ++bj)
#pragma unroll
                for (int n = 0; n < 2; ++n) cv[bj][n] = *(const f32x4*)(retg + 256 * (pn - 9) + 64 * wc + 32 * bj + 8 * fq + 4 * n); }
        float ifr[2][4];
#pragma unroll
        for (int bj = 0; bj < 2; ++bj)
#pragma unroll
            for (int p = 0; p < 4; ++p) ifr[bj][p] = __builtin_amdgcn_exp2f(-(float)(16 * bj + 4 * fq + p) * (13.287712379549449f / 31.0f)) * 0.15915494309189535f;
#pragma unroll
        for (int ai = 0; ai < 2; ++ai)
#pragma unroll
            for (int m = 0; m < 4; ++m) {
                const int row = rowb + ai * HALF + m * 16, b = row >> 12, t = row & 4095; const float rs = PG8_ROW_RS(lds0, u, row);
                f32x4 v[2][2];
#pragma unroll
                for (int bj = 0; bj < 2; ++bj)
#pragma unroll
                    for (int n = 0; n < 2; ++n) v[bj][n] = acc[ai][bj][m][n] * rs;
                if (pn < 2) {
                    float ss = 0.f;
#pragma unroll
                    for (int bj = 0; bj < 2; ++bj)
#pragma unroll
                        for (int n = 0; n < 2; ++n) ss += (v[bj][n][0] * v[bj][n][0] + v[bj][n][1] * v[bj][n][1]) + (v[bj][n][2] * v[bj][n][2] + v[bj][n][3] * v[bj][n][3]);
                    ss = xor32_sum(xor16_sum(ss));
                    float r = __builtin_amdgcn_rsqf(ss * (1.0f / 64.0f) + eps); if (pn == 0) r *= c2;
                    bf16_t* dst = (bf16_t*)(ws + (pn ? oKS : oQS)) + ((size_t)(b * 4 + wc) * 4096 + t) * 64 + 8 * fq;
#pragma unroll
                    for (int bj = 0; bj < 2; ++bj) { const f32x4 y0 = v[bj][0] * r * cv[bj][0], y1 = v[bj][1] * r * cv[bj][1];
                        u32x4 w; w.x = cvt_pk_bf16(y0[0], y0[1]); w.y = cvt_pk_bf16(y0[2], y0[3]); w.z = cvt_pk_bf16(y1[0], y1[1]); w.w = cvt_pk_bf16(y1[2], y1[3]); *(u32x4*)(dst + 32 * bj) = w; }
                } else if (pn == 2) {
#pragma unroll
                    for (int bj = 0; bj < 2; ++bj) { bf16_t* dst = (bf16_t*)(ws + oVS) + ((size_t)(b * 4 + wc) * 4096 + t) * 64 + 32 * bj + 8 * fq;
                        u32x4 w; w.x = cvt_pk_bf16(v[bj][0][0], v[bj][0][1]); w.y = cvt_pk_bf16(v[bj][0][2], v[bj][0][3]); w.z = cvt_pk_bf16(v[bj][1][0], v[bj][1][1]); w.w = cvt_pk_bf16(v[bj][1][2], v[bj][1][3]); *(u32x4*)dst = w; }
                } else if (pn < 7) {
                    const float sc = pn >= 5 ? 0.125f : 1.0f; const int head = 4 * ((pn - 3) & 1) + wc; const float tf = (float)t;
#pragma unroll
                    for (int bj = 0; bj < 2; ++bj) { float cs[4], sn[4];
#pragma unroll
                        for (int p = 0; p < 4; ++p) { const float rev = __builtin_amdgcn_fractf(tf * ifr[bj][p]); cs[p] = __builtin_amdgcn_cosf(rev) * sc; sn[p] = __builtin_amdgcn_sinf(rev) * sc; }
                        bf16_t* dst = (bf16_t*)(ws + (pn >= 5 ? oRK : oRQ)) + ((size_t)(b * 8 + head) * 4096 + t) * 64 + 32 * bj + 8 * fq;
                        const f32x4 a = v[bj][0], c = v[bj][1]; u32x4 w;
                        w.x = cvt_pk_bf16(a[0] * cs[0] - a[1] * sn[0], a[0] * sn[0] + a[1] * cs[0]); w.y = cvt_pk_bf16(a[2] * cs[1] - a[3] * sn[1], a[2] * sn[1] + a[3] * cs[1]);
                        w.z = cvt_pk_bf16(c[0] * cs[2] - c[1] * sn[2], c[0] * sn[2] + c[1] * cs[2]); w.w = cvt_pk_bf16(c[2] * cs[3] - c[3] * sn[3], c[2] * sn[3] + c[3] * cs[3]);
                        *(u32x4*)dst = w; }
                } else if (pn < 9) {
                    const int head = 4 * (pn - 7) + wc; const float lg2 = __builtin_amdgcn_logf(1.0f - __builtin_amdgcn_exp2f(-5.0f - (float)head)); const float sc = __builtin_amdgcn_exp2f(-(float)(t & 63) * lg2);
#pragma unroll
                    for (int bj = 0; bj < 2; ++bj) { bf16_t* dst = (bf16_t*)(ws + oRV) + ((size_t)(b * 8 + head) * 4096 + t) * 64 + 32 * bj + 8 * fq; const f32x4 a = v[bj][0] * sc, c = v[bj][1] * sc;
                        u32x4 w; w.x = cvt_pk_bf16(a[0], a[1]); w.y = cvt_pk_bf16(a[2], a[3]); w.z = cvt_pk_bf16(c[0], c[1]); w.w = cvt_pk_bf16(c[2], c[3]); *(u32x4*)dst = w; }
                } else if (pn < 11) {
#pragma unroll
                    for (int bj = 0; bj < 2; ++bj) { bf16_t* dst = (bf16_t*)(ws + oRG) + ((size_t)(b * 8 + 4 * (pn - 9) + wc) * 4096 + t) * 64 + 32 * bj + 8 * fq; f32x4 a = v[bj][0], c = v[bj][1];
#pragma unroll
                        for (int j = 0; j < 4; ++j) { a[j] = a[j] * __builtin_amdgcn_rcpf(1.0f + __builtin_amdgcn_exp2f(-1.4426950408889634f * a[j])) * cv[bj][0][j]; c[j] = c[j] * __builtin_amdgcn_rcpf(1.0f + __builtin_amdgcn_exp2f(-1.4426950408889634f * c[j])) * cv[bj][1][j]; }
                        u32x4 w; w.x = cvt_pk_bf16(a[0], a[1]); w.y = cvt_pk_bf16(a[2], a[3]); w.z = cvt_pk_bf16(c[0], c[1]); w.w = cvt_pk_bf16(c[2], c[3]); *(u32x4*)dst = w; }
                } else {
                    bf16_t* dst = (bf16_t*)(ws + oHC) + (size_t)row * 256 + 128 * (pn - 11) + 32 * wc + 8 * fq; f32x4 h[2];
#pragma unroll
                    for (int n = 0; n < 2; ++n) { const f32x4 a = v[0][n] + cv[0][n], g = v[1][n] + cv[1][n];
#pragma unroll
                        for (int j = 0; j < 4; ++j) h[n][j] = a[j] * __builtin_amdgcn_rcpf(1.0f + __builtin_amdgcn_exp2f(-1.4426950408889634f * g[j])); }
                    u32x4 w; w.x = cvt_pk_bf16(h[0][0], h[0][1]); w.y = cvt_pk_bf16(h[0][2], h[0][3]); w.z = cvt_pk_bf16(h[1][0], h[1][1]); w.w = cvt_pk_bf16(h[1][2], h[1][3]); *(u32x4*)dst = w;
                }
            }
    }
};

template <class Epi, class Sched, bool ALIGN_EPI = false, bool SP2 = false>
__device__ __forceinline__ void gemm_phase(PG8_LAS unsigned char* lds, const Gemm g, const Sched& S, const Epi& E) {
    int tid_ = threadIdx.x; asm volatile("" : "+v"(tid_));
    const int tid = tid_, wid = __builtin_amdgcn_readfirstlane(tid >> 6), lane = tid & 63, wr = wid >> 2, wc = wid & 3, fr = lane & 15, fq = lane >> 4;
    const int K = g.K, nt = K / BK;
    unsigned voffA[2], voffB[2];
#pragma unroll
    for (int i = 0; i < 2; ++i) { int R, C; stage_rc(tid * 16 + i * 8192, R, C); const int Rb = Epi::PERM ? (64 * (R >> 5) + perm32(R & 31)) : R;
        voffA[i] = (unsigned)(R * (g.a_blocked ? BK : K) + C) * 2u; voffB[i] = (unsigned)(Rb * K + C) * 2u; }
    const size_t kstep = (size_t)(BK * 2);
    const size_t hstep = (size_t)HALF * K * 2;
    const size_t tstep = 2 * hstep;
    const size_t hstepB = Epi::PERM ? (size_t)32 * K * 2 : hstep;
    const size_t kstepA = g.a_blocked ? (size_t)(HALF * BK * 2) : kstep, hstepA = g.a_blocked ? (size_t)(K / BK) * (HALF * BK * 2) : hstep, tstepA = 2 * hstepA;
    const unsigned ldsw = (unsigned)wid * 1024u;
    const int aoff = lds_byte(wr * 64 + fr, fq * 8), boff = lds_byte(wc * 32 + fr, fq * 8);
#define PG8_SA(b, h) (((b) * 2 + (h)) * HTB)
#define PG8_SB(b, h) ((4 + (b) * 2 + (h)) * HTB)
#define PG8_STAGE(bufoff, gbase, voff) do { _Pragma("unroll") for (int _i = 0; _i < 2; ++_i) \
        __builtin_amdgcn_global_load_lds((const unsigned*)((const char*)(gbase) + (voff)[_i]), (PG8_LAS unsigned*)(lds + (bufoff) + ldsw + _i * 8192), 16, 0, 0); } while (0)
#define PG8_LDA(dst, b, h) do { _Pragma("unroll") for (int m = 0; m < 4; ++m) _Pragma("unroll") for (int k = 0; k < 2; ++k) dst[m][k] = *(const PG8_LAS bf16x8*)(lds + PG8_SA(b, h) + aoff + m * 2048 + k * 1024); } while (0)
#define PG8_LDB(dst, b, h) do { _Pragma("unroll") for (int n = 0; n < 2; ++n) _Pragma("unroll") for (int k = 0; k < 2; ++k) dst[n][k] = *(const PG8_LAS bf16x8*)(lds + PG8_SB(b, h) + boff + n * 2048 + k * 1024); } while (0)
#define PG8_MMA(ai, bj, At, Bt) do { __builtin_amdgcn_s_setprio(1); _Pragma("unroll") for (int m = 0; m < 4; ++m) _Pragma("unroll") for (int n = 0; n < 2; ++n) _Pragma("unroll") for (int k = 0; k < 2; ++k) \
        acc[ai][bj][m][n] = __builtin_amdgcn_mfma_f32_16x16x32_bf16(Bt[n][k], At[m][k], acc[ai][bj][m][n], 0, 0, 0); __builtin_amdgcn_s_setprio(0); } while (0)
#define PG8_WAIT_V(n) asm volatile("s_waitcnt vmcnt(" #n ")" ::: "memory")
#define PG8_WAIT_L(n) asm volatile("s_waitcnt lgkmcnt(" #n ")" ::: "memory")
#define PG8_BAR __builtin_amdgcn_s_barrier()
#define PG8_SCHED __builtin_amdgcn_sched_barrier(0)
    Unit cur, nxt; int ui = 0;
    if (!S.next(0, cur)) return;
    f32x4 acc[2][2][4][2];
#pragma unroll
    for (int a = 0; a < 2; ++a)
#pragma unroll
        for (int b = 0; b < 2; ++b)
#pragma unroll
            for (int m = 0; m < 4; ++m)
#pragma unroll
                for (int n = 0; n < 2; ++n) acc[a][b][m][n] = (f32x4){0.f, 0.f, 0.f, 0.f};
    bf16x8 At[4][2], B0[2][2], B1[2][2];
    const char* cA = (const char*)g.A + (size_t)cur.pm * tstepA; const char* cB = (const char*)g.Bt + (size_t)cur.pn * tstep;
    S.a_ready(cur);
    if constexpr (SP2) {
        PG8_STAGE(PG8_SB(0, 0), cB, voffB); PG8_STAGE(PG8_SB(0, 1), cB + hstepB, voffB); PG8_STAGE(PG8_SA(0, 0), cA, voffA); PG8_STAGE(PG8_SA(0, 1), cA + hstepA, voffA);
        if (wr == 1) PG8_BAR;
        PG8_WAIT_V(2); PG8_BAR;
        PG8_STAGE(PG8_SB(1, 0), cB + kstep, voffB); PG8_STAGE(PG8_SA(1, 0), cA + kstepA, voffA); PG8_STAGE(PG8_SB(1, 1), cB + hstepB + kstep, voffB);
        PG8_WAIT_V(6); PG8_BAR;
    } else {
        PG8_STAGE(PG8_SB(0, 0), cB, voffB); PG8_STAGE(PG8_SA(0, 0), cA, voffA); PG8_STAGE(PG8_SB(0, 1), cB + hstepB, voffB); PG8_STAGE(PG8_SA(0, 1), cA + hstepA, voffA);
        if (wr == 1) PG8_BAR;
        PG8_WAIT_V(4); PG8_BAR;
        PG8_STAGE(PG8_SB(1, 0), cB + kstep, voffB); PG8_STAGE(PG8_SA(1, 0), cA + kstepA, voffA); PG8_STAGE(PG8_SB(1, 1), cB + hstepB + kstep, voffB);
        PG8_WAIT_V(6); PG8_BAR;
    }
    for (;;) {
        const bool has_next = S.next(ui + 1, nxt);
        const char* nA = has_next ? (const char*)g.A + (size_t)nxt.pm * tstepA : cA; const char* nB = has_next ? (const char*)g.Bt + (size_t)nxt.pn * tstep : cB;
        for (int t = 0; t < nt; t += 2) {
            const bool last = (t == nt - 2);
            const char* a1 = cA + (size_t)(t + 1) * kstepA;
            const char* a2 = last ? nA : cA + (size_t)(t + 2) * kstepA; const char* b2 = last ? nB : cB + (size_t)(t + 2) * kstep;
            const char* a3 = a2 + kstepA; const char* b3 = b2 + kstep;
            if (last && has_next) S.a_ready(nxt);
            if constexpr (SP2) {
            PG8_LDB(B0, 0, 0); PG8_LDB(B1, 0, 1); PG8_SCHED; PG8_LDA(At, 0, 0); PG8_STAGE(PG8_SA(1, 1), a1 + hstepA, voffA);
            PG8_WAIT_V(8); PG8_WAIT_L(0); PG8_BAR; PG8_MMA(0, 0, At, B0); PG8_MMA(0, 1, At, B1); PG8_BAR; PG8_SCHED;
            PG8_LDA(At, 0, 1); PG8_STAGE(PG8_SB(0, 0), b2, voffB); PG8_STAGE(PG8_SB(0, 1), b2 + hstepB, voffB); PG8_STAGE(PG8_SA(0, 0), a2, voffA);
            PG8_WAIT_V(8); PG8_WAIT_L(0); PG8_BAR; PG8_MMA(1, 0, At, B0); PG8_MMA(1, 1, At, B1); PG8_BAR; PG8_SCHED;
            PG8_LDB(B0, 1, 0); PG8_LDB(B1, 1, 1); PG8_SCHED; PG8_LDA(At, 1, 0); PG8_STAGE(PG8_SA(0, 1), a2 + hstepA, voffA);
            PG8_WAIT_V(8); PG8_WAIT_L(0); PG8_BAR; PG8_MMA(0, 0, At, B0); PG8_MMA(0, 1, At, B1); PG8_BAR; PG8_SCHED;
            PG8_LDA(At, 1, 1); PG8_STAGE(PG8_SB(1, 0), b3, voffB); PG8_STAGE(PG8_SB(1, 1), b3 + hstepB, voffB); PG8_STAGE(PG8_SA(1, 0), a3, voffA);
            PG8_WAIT_V(8); PG8_WAIT_L(0); PG8_BAR; PG8_MMA(1, 0, At, B0); PG8_MMA(1, 1, At, B1); PG8_BAR; PG8_SCHED;
            } else {
            PG8_LDB(B0, 0, 0); PG8_SCHED; PG8_LDA(At, 0, 0); PG8_STAGE(PG8_SA(1, 1), a1 + hstepA, voffA);
            PG8_WAIT_L(8); PG8_BAR; PG8_WAIT_L(0); PG8_MMA(0, 0, At, B0); PG8_BAR; PG8_SCHED;
            PG8_LDB(B1, 0, 1); PG8_STAGE(PG8_SB(0, 0), b2, voffB);
            PG8_BAR; PG8_WAIT_L(0); PG8_MMA(0, 1, At, B1); PG8_BAR;
            PG8_LDA(At, 0, 1); PG8_STAGE(PG8_SA(0, 0), a2, voffA);
            PG8_BAR; PG8_WAIT_L(0); PG8_MMA(1, 0, At, B0); PG8_BAR; PG8_SCHED;
            PG8_STAGE(PG8_SB(0, 1), b2 + hstepB, voffB);
            PG8_WAIT_V(6); PG8_BAR; PG8_MMA(1, 1, At, B1); PG8_BAR;
            PG8_LDB(B0, 1, 0); PG8_SCHED; PG8_LDA(At, 1, 0); PG8_STAGE(PG8_SA(0, 1), a2 + hstepA, voffA);
            PG8_WAIT_L(8); PG8_BAR; PG8_WAIT_L(0); PG8_MMA(0, 0, At, B0); PG8_BAR; PG8_SCHED;
            PG8_LDB(B1, 1, 1); PG8_STAGE(PG8_SB(1, 0), b3, voffB);
            PG8_BAR; PG8_WAIT_L(0); PG8_MMA(0, 1, At, B1); PG8_BAR;
            PG8_LDA(At, 1, 1); PG8_STAGE(PG8_SA(1, 0), a3, voffA);
            PG8_BAR; PG8_WAIT_L(0); PG8_MMA(1, 0, At, B0); PG8_BAR; PG8_SCHED;
            PG8_STAGE(PG8_SB(1, 1), b3 + hstepB, voffB);
            PG8_WAIT_V(6); PG8_BAR; PG8_MMA(1, 1, At, B1); PG8_BAR;
            }
        }
        if constexpr (ALIGN_EPI) { if (wr == 0) PG8_BAR; }
        if constexpr (!Epi::AFTER_DRAIN) { E(acc, cur, wr, wc, fr, fq); S.done(cur); }
        if (!has_next) break;
#pragma unroll
        for (int a = 0; a < 2; ++a)
#pragma unroll
            for (int b = 0; b < 2; ++b)
#pragma unroll
                for (int m = 0; m < 4; ++m)
#pragma unroll
                    for (int n = 0; n < 2; ++n) acc[a][b][m][n] = (f32x4){0.f, 0.f, 0.f, 0.f};
        cur = nxt; cA = nA; cB = nB; ++ui;
        if constexpr (ALIGN_EPI) { if (wr == 1) PG8_BAR; }
    }
    PG8_WAIT_V(0);
    if constexpr (!ALIGN_EPI) { if (wr == 0) PG8_BAR; }
    PG8_BAR;
    if constexpr (Epi::AFTER_DRAIN) { E.fused(acc, cur, wr, wc, fr, fq, lds, wid, lane); S.done(cur); }
#undef PG8_SA
#undef PG8_SB
#undef PG8_STAGE
#undef PG8_LDA
#undef PG8_LDB
#undef PG8_MMA
#undef PG8_WAIT_V
#undef PG8_WAIT_L
#undef PG8_BAR
#undef PG8_SCHED
}
}
#ifndef PG8_SP2
#define PG8_SP2 true
#endif
#ifndef PG8_ALIGN
#define PG8_ALIGN true
#endif

constexpr int NWAVES = 8;
constexpr int BATCH = 8, SEQ = 4096, DM = 1024, DEPTH = 2, M = BATCH * SEQ;
constexpr int HD = 64, SBH = 4, SBW = 256, RH = 8, RW = 512, CW = 256, CK = 31, DFF = 4096, INC = 3328;
constexpr float EPS = 1e-6f;
constexpr float SB_C2 = 0.125f * 1.4426950408889634f;
constexpr size_t MiB = 1u << 20;
constexpr size_t WS_CTL = 0, CTL_ZERO_BYTES = 32768;
constexpr size_t WS_W = 2 * MiB, W_LAYER = 25 * MiB, W_IN = 0, W_OUT = 7 * MiB, W_1 = 9 * MiB, W_2 = 17 * MiB;
constexpr size_t WS_SSQ = 53 * MiB;
constexpr size_t WS_XNG = 56 * MiB;
constexpr size_t WS_RT = 216 * MiB;
constexpr size_t WS_RQT = 232 * MiB;
constexpr size_t WS_RP = 240 * MiB;
constexpr size_t WS_RG = 184 * MiB;
constexpr size_t WS_R = 120 * MiB;
constexpr size_t WS_MIX = WS_R, WS_F = WS_R;
constexpr size_t WS_QS = 328 * MiB, WS_KS = 344 * MiB, WS_VS = 360 * MiB;
constexpr size_t WS_RQ = 376 * MiB, WS_RK = 408 * MiB, WS_RV = 440 * MiB;
constexpr size_t WS_HC = 472 * MiB;
constexpr size_t WS_END = 488 * MiB;
static_assert(WS_RQT + 4 * MiB <= WS_QS && WS_F + (size_t)M * DFF * 2 <= WS_HC && WS_HC + (size_t)M * CW * 2 <= WS_END, "d_ws map");
constexpr int CW_BAR = 4096;
constexpr int RING_OFF = 0, RING_BYTES = 131072, LDSCTL_OFF = RING_BYTES, MISC_OFF = LDSCTL_OFF + 320, LDS_BYTES = 147456;

#define GAS __attribute__((address_space(1)))
#define LAS __attribute__((address_space(3)))
typedef unsigned short bf16;
typedef unsigned v4u __attribute__((ext_vector_type(4)));
typedef unsigned v2u __attribute__((ext_vector_type(2)));
typedef float f32x4 __attribute__((ext_vector_type(4)));
#define LDS_WAIT() asm volatile("s_waitcnt lgkmcnt(0)" ::: "memory")
#define VM_WAIT() asm volatile("s_waitcnt vmcnt(0)" ::: "memory")
__device__ __forceinline__ float bf2f(unsigned h) { return __uint_as_float(h << 16); }
__device__ __forceinline__ float bflo(unsigned w) { return __uint_as_float(w << 16); }
__device__ __forceinline__ float bfhi(unsigned w) { return __uint_as_float(w & 0xffff0000u); }
__device__ __forceinline__ unsigned pk2(float lo, float hi) { return pg8::cvt_pk_bf16(lo, hi); }
template <int CTRL> __device__ __forceinline__ float dpp_f(float v) { return __int_as_float(__builtin_amdgcn_update_dpp(0, __float_as_int(v), CTRL, 0xF, 0xF, true)); }
__device__ __forceinline__ float xor16_sum(float v) { const auto r = __builtin_amdgcn_permlane16_swap(__float_as_uint(v), __float_as_uint(v), false, false); return __uint_as_float(r[0]) + __uint_as_float(r[1]); }
__device__ __forceinline__ float xor32_sum(float v) { const auto r = __builtin_amdgcn_permlane32_swap(__float_as_uint(v), __float_as_uint(v), false, false); return __uint_as_float(r[0]) + __uint_as_float(r[1]); }
__device__ __forceinline__ float wave_sum(float v) {
    v += dpp_f<0xB1>(v); v += dpp_f<0x4E>(v); v += dpp_f<0x141>(v); v += dpp_f<0x140>(v);
    return xor32_sum(xor16_sum(v));
}

#define XB_TMO      128
#define XB_XCNT(j)  (256  + 64 * (j))
#define XB_XSUB(j)  (1280 + 64 * (j))
#define XB_XGEN(j)  (2304 + 64 * (j))
#define XB_TOP      3328
#define XB_TOPGEN   3392
#define XCD_BAR_WORDS 3456
#define XB_SPIN_CAP (1u << 18)

__device__ __forceinline__ unsigned xb_ld(unsigned* p)              { return __hip_atomic_load(p, __ATOMIC_RELAXED, __HIP_MEMORY_SCOPE_AGENT); }
__device__ __forceinline__ unsigned xb_add(unsigned* p, unsigned v) { return __hip_atomic_fetch_add(p, v, __ATOMIC_RELAXED, __HIP_MEMORY_SCOPE_AGENT); }
__device__ __forceinline__ unsigned xb_xcc_id() { return (unsigned)__builtin_amdgcn_s_getreg((3 << 11) | 20) & 0xFu; }
#define XB_SPIN(cond, bar) do { unsigned _sp = 0; while (cond) { __builtin_amdgcn_s_sleep(1); \
    if ((++_sp & 255u) == 0u) { if (xb_ld(&(bar)[XB_TMO])) break; if (_sp > XB_SPIN_CAP) { atomicAdd(&(bar)[XB_TMO], 1u); break; } } } } while (0)

struct XcdBarrier {
    unsigned* bar; unsigned x;
    volatile LAS unsigned* st;
};

__device__ __forceinline__ XcdBarrier xcd_barrier_post(unsigned* bar, volatile LAS unsigned* st) {
    XcdBarrier b; b.bar = bar; b.x = xb_xcc_id(); b.st = st;
    if (threadIdx.x == 0) (void)xb_add(&bar[XB_XCNT(b.x)], 1u);
    return b;
}
__device__ __forceinline__ void xcd_barrier_complete(unsigned* bar, unsigned x, unsigned& nloc, unsigned& nx) {
    const unsigned G = gridDim.x * gridDim.y * gridDim.z;
    unsigned sum, cnt, mine, sp = 0u;
    for (;;) {
        sum = 0u; cnt = 0u; mine = 0u;
#pragma unroll
        for (unsigned j = 0; j < 16; ++j) { const unsigned c = xb_ld(&bar[XB_XCNT(j)]); sum += c; cnt += (c > 0u) ? 1u : 0u; mine = (j == x) ? c : mine; }
        if (sum == G) break;
        __builtin_amdgcn_s_sleep(1);
        if ((++sp & 255u) == 0u) { if (xb_ld(&bar[XB_TMO])) break; if (sp > XB_SPIN_CAP) { atomicAdd(&bar[XB_TMO], 1u); break; } }
    }
    nloc = mine > 0u ? mine : 1u; nx = cnt > 0u ? cnt : 1u;
}

__device__ __forceinline__ void xcd_barrier(const XcdBarrier& b) {
    asm volatile("s_waitcnt vmcnt(0)" ::: "memory");
    __syncthreads();
    if (threadIdx.x == 0) {
        unsigned* bar = b.bar;
        __builtin_amdgcn_s_waitcnt(0);
        unsigned nloc = b.st[0], nx = b.st[1];
        if (nloc == 0u) { xcd_barrier_complete(bar, b.x, nloc, nx); b.st[0] = nloc; b.st[1] = nx; }
        const unsigned old = xb_add(&bar[XB_XSUB(b.x)], 1u);
        const unsigned gen = old / nloc;
        if (old + 1u == (gen + 1u) * nloc) {
            __builtin_amdgcn_fence(__ATOMIC_RELEASE, "agent");
            asm volatile("s_waitcnt vmcnt(0)" ::: "memory");
            const unsigned og = xb_add(&bar[XB_TOP], 1u);
            const unsigned tg = og / nx;
            if (og + 1u == (tg + 1u) * nx) xb_add(&bar[XB_TOPGEN], 1u);
            else XB_SPIN(xb_ld(&bar[XB_TOPGEN]) == tg, bar);
            __builtin_amdgcn_fence(__ATOMIC_ACQUIRE, "agent");
            xb_add(&bar[XB_XGEN(b.x)], 1u);
            asm volatile("s_waitcnt vmcnt(0)" ::: "memory");
        } else {
            XB_SPIN(xb_ld(&bar[XB_XGEN(b.x)]) == gen, bar);
            __builtin_amdgcn_fence(__ATOMIC_ACQUIRE, "agent");
            asm volatile("s_waitcnt vmcnt(0)" ::: "memory");
        }
    }
    __syncthreads();
}

struct Args {
    const float* x; const float* mix_g; const float* w_in; const float* sbq_g; const float* sbk_g; const float* ret_g; const float* pw_b; const float* dw_w; const float* dw_b;
    const float* ln_g; const float* ln_b; const float* w_out; const float* mlp_g; const float* w_ff1; const float* w_ff2;
    float* out; unsigned char* ws;
    float ret_lg2[8];
    int ph_lo, ph_hi;
};

struct Frame {
    LAS unsigned char* lds;
    int tid, lane, wave, gw;
    unsigned char* ws;
};

template <bool INPROJ> __device__ __forceinline__ void p0_transpose_item(const float* W, const float* gk, int K, int N, bf16* WT, LAS float* scr, int item, int lane) {
    const int nblk = N / 32, kb = item / nblk, nb = item % nblk, k0 = 64 * kb, r0 = 32 * nb, n0 = INPROJ ? pg8::inproj_srccol(r0) : r0;
    float wv[32];
#pragma unroll
    for (int i = 0; i < 32; ++i) wv[i] = __builtin_nontemporal_load(W + (size_t)(k0 + 2 * i + (lane >> 5)) * N + n0 + (lane & 31));
    if (gk) {
#pragma unroll
        for (int i = 0; i < 32; ++i) wv[i] *= gk[k0 + 2 * i + (lane >> 5)]; }
#pragma unroll
    for (int i = 0; i < 32; ++i) scr[(2 * i + (lane >> 5)) * 33 + (lane & 31)] = wv[i];
    LDS_WAIT(); asm volatile("" ::: "memory");
    const int c = lane & 7;
#pragma unroll
    for (int j = 0; j < 4; ++j) { const int n = (lane >> 3) + 8 * j; const LAS float* s = scr + (8 * c) * 33 + n;
        v4u o; o.x = pk2(s[0 * 33], s[1 * 33]); o.y = pk2(s[2 * 33], s[3 * 33]); o.z = pk2(s[4 * 33], s[5 * 33]); o.w = pk2(s[6 * 33], s[7 * 33]);
        *(v4u*)(WT + (size_t)(r0 + n) * K + k0 + 8 * c) = o; }
    LDS_WAIT(); asm volatile("" ::: "memory");
}
__device__ __forceinline__ void xng_row2(const float* x, int m0, int m1, bf16* xb_all, float* ssq, int lane) {
    const f32x4* x0 = (const f32x4*)(x + (size_t)m0 * DM) + lane; const f32x4* x1 = (const f32x4*)(x + (size_t)m1 * DM) + lane;
    f32x4 v[2][4];
#pragma unroll
    for (int j = 0; j < 4; ++j) { v[0][j] = __builtin_nontemporal_load(x0 + 64 * j); v[1][j] = __builtin_nontemporal_load(x1 + 64 * j); }
#pragma unroll
    for (int r = 0; r < 2; ++r) { const int m_row = r ? m1 : m0; float s = 0.f;
#pragma unroll
        for (int j = 0; j < 4; ++j) s += (v[r][j][0] * v[r][j][0] + v[r][j][1] * v[r][j][1]) + (v[r][j][2] * v[r][j][2] + v[r][j][3] * v[r][j][3]);
        s = wave_sum(s);
#pragma unroll
        for (int j = 0; j < 4; ++j) { const f32x4 y = v[r][j]; v2u w; w.x = pk2(y[0], y[1]); w.y = pk2(y[2], y[3]); const int c = 4 * lane + 256 * j;
            *(v2u*)(xb_all + ((size_t)((m_row >> 7) * 16 + (c >> 6)) * 8192 + (m_row & 127) * 64 + (c & 63))) = w; }
        if (lane < 16) ssq[(size_t)m_row * 16 + lane] = lane == 0 ? s : 0.f; }
}
constexpr int CVT_I_IN = (DM / 64) * (INC / 32), CVT_I_OUT = (DM / 64) * (DM / 32), CVT_I_1 = (DM / 64) * (DFF / 32), CVT_I_2 = (DFF / 64) * (DM / 32), CVT_I_L = CVT_I_IN + CVT_I_OUT + CVT_I_1 + CVT_I_2;
__device__ __forceinline__ void convert_weights(Frame& F, const Args& A, int first, int last, int stride_id, int stride) {
    LAS float* scr = (LAS float*)(F.lds + RING_OFF + F.wave * 16384);
    constexpr int I_IN = CVT_I_IN, I_OUT = CVT_I_OUT, I_1 = CVT_I_1, I_L = CVT_I_L;
    for (int it = first + stride_id; it < last; it += stride) {
        const int l = it / I_L; int r = it % I_L; unsigned char* wl = F.ws + WS_W + (size_t)l * W_LAYER;
        if (r < I_IN) { p0_transpose_item<true>(A.w_in + (size_t)l * DM * INC, A.mix_g + l * DM, DM, INC, (bf16*)(wl + W_IN), scr, r, F.lane); continue; } r -= I_IN;
        if (r < I_OUT) { p0_transpose_item<false>(A.w_out + (size_t)l * DM * DM, nullptr, DM, DM, (bf16*)(wl + W_OUT), scr, r, F.lane); continue; } r -= I_OUT;
        if (r < I_1) { p0_transpose_item<false>(A.w_ff1 + (size_t)l * DM * DFF, A.mlp_g + l * DM, DM, DFF, (bf16*)(wl + W_1), scr, r, F.lane); continue; } r -= I_1;
        p0_transpose_item<false>(A.w_ff2 + (size_t)l * DFF * DM, nullptr, DFF, DM, (bf16*)(wl + W_2), scr, r, F.lane);
    }
}
__device__ __forceinline__ void p0_prologue(Frame& F, const Args& A) {
    const int NGW = gridDim.x * NWAVES;
    convert_weights(F, A, 0, CVT_I_IN, F.gw, NGW);
    for (int m = F.gw; m < M / 2; m += NGW) {
        xng_row2(A.x, m, m + M / 2, (bf16*)(F.ws + WS_XNG), (float*)(F.ws + WS_SSQ), F.lane); }
}

__device__ __forceinline__ float sigmoidf_(float x) { return __builtin_amdgcn_rcpf(1.0f + __builtin_amdgcn_exp2f(-1.4426950408889634f * x)); }

namespace sba {
typedef short bf16x8 __attribute__((ext_vector_type(8)));
typedef short s16x4 __attribute__((ext_vector_type(4)));
typedef float f32x16 __attribute__((ext_vector_type(16)));
typedef unsigned u32x4 __attribute__((ext_vector_type(4)));
typedef float f32x2_t __attribute__((ext_vector_type(2))); typedef __bf16 bf16x2_t __attribute__((ext_vector_type(2)));
__device__ __forceinline__ unsigned cvtpk(float lo, float hi) { const f32x2_t v = {lo, hi}; const bf16x2_t b = __builtin_convertvector(v, bf16x2_t); return __builtin_bit_cast(unsigned, b); }
__device__ __forceinline__ bf16x8 frag8(const f32x16& x, int s) {
    u32x4 w; w.x = cvtpk(x[8 * s + 0], x[8 * s + 1]); w.y = cvtpk(x[8 * s + 2], x[8 * s + 3]); w.z = cvtpk(x[8 * s + 4], x[8 * s + 5]); w.w = cvtpk(x[8 * s + 6], x[8 * s + 7]);
    return __builtin_bit_cast(bf16x8, w);
}
__device__ __forceinline__ s16x4 vtr(const LAS unsigned char* p) { typedef short v4i16_t __attribute__((ext_vector_type(4))); return __builtin_bit_cast(s16x4, __builtin_amdgcn_ds_read_tr16_b64_v4i16((LAS v4i16_t*)p)); }
constexpr int SB_LDS = 65536; constexpr float SB_EXIT = 160.0f;

template <bool DIAG> __device__ __forceinline__ void sb_subtile(const LAS unsigned char* Kb, const LAS unsigned char* Vb, int hf, int r32, int hi, unsigned vlane, const bf16x8 (&qr)[4],
                                                                bf16x8 U0n, bf16x8 U1n, bf16x8 ONn, f32x16& o0, f32x16& o1, f32x16& carry) {
    f32x16 z;
#pragma unroll
    for (int r = 0; r < 16; ++r) z[r] = 0.f;
#pragma unroll
    for (int d0 = 0; d0 < 4; ++d0) { const bf16x8 kf = *(const LAS bf16x8*)(Kb + (2 * d0 + hi) * 1024 + (32 * hf + r32) * 16); z = __builtin_amdgcn_mfma_f32_32x32x16_bf16(kf, qr[d0], z, 0, 0, 0); }
    f32x16 sp;
#pragma unroll
    for (int r = 0; r < 16; ++r) { const float zz = z[r]; const float e = __builtin_amdgcn_exp2f(-fabsf(zz)); sp[r] = __builtin_fmaf(0.5f, zz + fabsf(zz), __builtin_amdgcn_logf(1.0f + e)); }
    if (DIAG) {
#pragma unroll
        for (int r = 0; r < 16; ++r) { const int keyl = (r & 3) + 8 * (r >> 2) + 4 * hi; if (!(keyl < r32)) sp[r] = 0.f; }
    }
    const bf16x8 x0 = frag8(sp, 0), x1 = frag8(sp, 1);
    f32x16 T = __builtin_amdgcn_mfma_f32_32x32x16_bf16(U0n, x0, carry, 0, 0, 0); T = __builtin_amdgcn_mfma_f32_32x32x16_bf16(U1n, x1, T, 0, 0, 0);
    carry = __builtin_amdgcn_mfma_f32_32x32x16_bf16(ONn, x0, carry, 0, 0, 0); carry = __builtin_amdgcn_mfma_f32_32x32x16_bf16(ONn, x1, carry, 0, 0, 0);
    f32x16 w;
#pragma unroll
    for (int r = 0; r < 16; ++r) w[r] = __builtin_amdgcn_exp2f(z[r] + T[r]);
    if (DIAG) {
#pragma unroll
        for (int r = 0; r < 16; ++r) { const int keyl = (r & 3) + 8 * (r >> 2) + 4 * hi; if (!(keyl < r32)) w[r] = 0.f; }
    }
    const bf16x8 w0 = frag8(w, 0), w1 = frag8(w, 1);
#pragma unroll
    for (int ks = 0; ks < 2; ++ks) { const LAS unsigned char* vp = Vb + vlane + (32 * hf + 16 * ks) * 64;
        const s16x4 a0 = vtr(vp), a1 = vtr(vp + 512), b0 = vtr(vp + 4096), b1 = vtr(vp + 4096 + 512);
        const bf16x8 v0 = (bf16x8){a0[0], a0[1], a0[2], a0[3], a1[0], a1[1], a1[2], a1[3]}, v1 = (bf16x8){b0[0], b0[1], b0[2], b0[3], b1[0], b1[1], b1[2], b1[3]};
        o0 = __builtin_amdgcn_mfma_f32_32x32x16_bf16(ks ? w1 : w0, v0, o0, 0, 0, 0); o1 = __builtin_amdgcn_mfma_f32_32x32x16_bf16(ks ? w1 : w0, v1, o1, 0, 0, 0); }
}
__device__ __forceinline__ void sb_unit(int bh, int qb, const bf16* Qs, const bf16* Ks, const bf16* Vs, bf16* MIX, LAS unsigned char* lds, int tid) {
    const int lane = tid & 63, wave = __builtin_amdgcn_readfirstlane(tid >> 6), r32 = lane & 31, hi = lane >> 5, quad = wave >> 2, tq = tid & 255;
    const int q0 = qb * 256 + quad * 128 + (quad ? 3 - (wave & 3) : (wave & 3)) * 32; const size_t hb = (size_t)bh * SEQ * HD;
    bf16x8 qr[4];
#pragma unroll
    for (int d0 = 0; d0 < 4; ++d0) qr[d0] = *(const bf16x8*)(Qs + hb + (size_t)(q0 + r32) * HD + 16 * d0 + 8 * hi);
    bf16x8 U0, U1, ON;
#pragma unroll
    for (int j = 0; j < 8; ++j) { const int k0 = 8 * (j >> 2) + 4 * hi + (j & 3); U0[j] = (k0 >= r32) ? (short)0xBF80 : (short)0; U1[j] = (16 + k0 >= r32) ? (short)0xBF80 : (short)0; ON[j] = (short)0xBF80; }
    f32x16 o0, o1, carry;
#pragma unroll
    for (int r = 0; r < 16; ++r) { o0[r] = 0.f; o1[r] = 0.f; carry[r] = 0.f; }
    const int NT = 4 * qb + 2 + 2 * quad, NSTEP = 4 * qb + 4;
    LAS unsigned char* ldq = lds + quad * 32768;
    unsigned kdst[2], vdst[2];
#pragma unroll
    for (int i = 0; i < 2; ++i) { const int p = tq + 256 * i, key_i = p >> 3, c_i = p & 7; kdst[i] = (unsigned)(c_i * 1024 + key_i * 16); vdst[i] = (unsigned)(8192 + (c_i >> 2) * 4096 + key_i * 64 + (c_i & 3) * 16); }
    const v4u* kg = (const v4u*)(Ks + hb) + tq; const v4u* vg = (const v4u*)(Vs + hb) + tq;
    {
#pragma unroll
        for (int i = 0; i < 2; ++i) { const v4u kx = kg[(size_t)(NT - 1) * 512 + 256 * i], vx = vg[(size_t)(NT - 1) * 512 + 256 * i]; *(LAS v4u*)(ldq + kdst[i]) = kx; *(LAS v4u*)(ldq + vdst[i]) = vx; } }
    __syncthreads();
    const unsigned vlane = (unsigned)(((lane >> 4) & 1) * 32 + (lane & 3) * 8 + (4 * hi + ((lane & 15) >> 2)) * 64);
    int cur = 0;
    for (int i = 0; i < NSTEP; ++i) {
        const int kt = NT - 1 - i;
        v4u kx[2], vx[2];
        if (kt > 0) {
#pragma unroll
            for (int j = 0; j < 2; ++j) { kx[j] = kg[(size_t)(kt - 1) * 512 + 256 * j]; vx[j] = vg[(size_t)(kt - 1) * 512 + 256 * j]; } }
        const bool wfin = __all(carry[0] <= -SB_EXIT);
        if (kt >= 0 && !wfin) {
            const LAS unsigned char* Kb = ldq + cur * 16384; const LAS unsigned char* Vb = Kb + 8192;
#pragma unroll
            for (int hf = 1; hf >= 0; --hf) {
                const int kbase = kt * 64 + hf * 32;
                if (kbase <= q0 && (hf == 1 || !__all(carry[0] <= -SB_EXIT))) {
                    if (kbase == q0) sb_subtile<true>(Kb, Vb, hf, r32, hi, vlane, qr, U0, U1, ON, o0, o1, carry);
                    else sb_subtile<false>(Kb, Vb, hf, r32, hi, vlane, qr, U0, U1, ON, o0, o1, carry);
                }
            }
        }
        if (kt > 0) {
#pragma unroll
            for (int j = 0; j < 2; ++j) { *(LAS v4u*)(ldq + (cur ^ 1) * 16384 + kdst[j]) = kx[j]; *(LAS v4u*)(ldq + (cur ^ 1) * 16384 + vdst[j]) = vx[j]; } }
        const int wdone = (kt <= 0) || ((kt * 64 <= q0) && __all(carry[0] <= -SB_EXIT));
        if (__syncthreads_and(wdone)) break;
        cur ^= 1;
    }
    const int b = bh >> 2, hh = bh & 3;
    LAS unsigned char* ow = lds - 65536 + wave * 4096;
#pragma unroll
    for (int r = 0; r < 16; ++r) { const int row = (r & 3) + 8 * (r >> 2) + 4 * hi; const unsigned pk = cvtpk(o0[r], o1[r]);
        *(LAS unsigned short*)(ow + row * 128 + r32 * 2) = (unsigned short)(pk & 0xffffu); *(LAS unsigned short*)(ow + row * 128 + 64 + r32 * 2) = (unsigned short)(pk >> 16); }
    asm volatile("s_waitcnt lgkmcnt(0)" ::: "memory");
#pragma unroll
    for (int i = 0; i < 4; ++i) { const int c = lane + 64 * i, row = c >> 3, cc = c & 7, t = q0 + row; const v4u v = *(const LAS v4u*)(ow + row * 128 + cc * 16);
        *(v4u*)(MIX + (((size_t)((b * SEQ + t) >> 7) * 16 + (hh)) * 8192 + ((b * SEQ + t) & 127) * 64 + cc * 8)) = v; }
}
__device__ __forceinline__ void sb_phase(Frame& F) {
    const int G = gridDim.x, bx = blockIdx.x; const int vcu = (G % 8 == 0) ? (bx % 8) * (G / 8) + bx / 8 : bx;
    const bf16 *Qs = (const bf16*)(F.ws + WS_QS), *Ks = (const bf16*)(F.ws + WS_KS), *Vs = (const bf16*)(F.ws + WS_VS); bf16* MIX = (bf16*)(F.ws + WS_MIX);
    for (int u = vcu; u < 256; u += G) { const int bh = u >> 3, s = u & 7;
        sb_unit(bh, s, Qs, Ks, Vs, MIX, F.lds + RING_OFF + 65536, F.tid);
        sb_unit(bh, 15 - s, Qs, Ks, Vs, MIX, F.lds + RING_OFF + 65536, F.tid); }
}
}

__device__ __forceinline__ void conv_phase(Frame& F, const Args& A, int l) {
    const int tid = F.tid, c = tid & 255, th = tid >> 8, lane = F.lane, wave = F.wave;
    LAS float* cbuf = (LAS float*)(F.lds + RING_OFF + 65536);
    const bf16* Hc = (const bf16*)(F.ws + WS_HC); bf16* MIX = (bf16*)(F.ws + WS_MIX);
    const float* dww = A.dw_w + (size_t)l * CK * CW; const float bias = A.dw_b[l * CW + c];
    float w[CK];
#pragma unroll
    for (int j = 0; j < CK; ++j) w[j] = dww[j * CW + c];
    typedef float f32x2c __attribute__((ext_vector_type(2))); f32x2c wp[CK];
#pragma unroll
    for (int j = 1; j < CK; ++j) wp[j] = (f32x2c){w[j], w[j - 1]};
    wp[0] = (f32x2c){0.f, 0.f};
    const f32x4 lg = *(const f32x4*)(A.ln_g + l * CW + 4 * lane), lb = *(const f32x4*)(A.ln_b + l * CW + 4 * lane);
    for (int tile = blockIdx.x; tile < M / 64; tile += gridDim.x) {
        const int row0 = tile * 64 + 32 * th, tb = row0 % SEQ, bstart = row0 - tb;
        f32x2c acc2[16];
#pragma unroll
        for (int j = 0; j < 16; ++j) acc2[j] = (f32x2c){bias, bias};
        unsigned short hv[62];
        const bf16* hp = Hc + ((ptrdiff_t)row0 - (CK - 1)) * CW + c;
#pragma unroll
        for (int q = 0; q < 62; ++q) hv[q] = hp[q * CW];
        asm volatile("" ::: "memory");
        if (tb < CK - 1) {
#pragma unroll
            for (int q = 0; q < CK - 1; ++q) { const bool ok = (row0 - (CK - 1) + q) >= bstart; hv[q] = ok ? hv[q] : (unsigned short)0; } }
#pragma unroll
        for (int q = 0; q < 62; ++q) {
            const float x = bf2f(hv[q]); const f32x2c xx = {x, x};
            const int olo = (q > 30 ? q - 30 : 0), ohi = (q < 31 ? q : 31);
            if (olo & 1) acc2[olo >> 1][1] += w[q - olo] * x;
#pragma unroll
            for (int o = (olo + 1) & ~1; o + 1 <= ohi; o += 2) acc2[o >> 1] = __builtin_elementwise_fma(wp[q - o], xx, acc2[o >> 1]);
            if (!(ohi & 1) && ohi >= olo) acc2[ohi >> 1][0] += w[q - ohi] * x;
        }
#pragma unroll
        for (int o = 0; o < 32; ++o) cbuf[(32 * th + o) * CW + c] = acc2[o >> 1][o & 1];
        __syncthreads();
        f32x4 v8[8];
#pragma unroll
        for (int k = 0; k < 8; ++k) v8[k] = *(const LAS f32x4*)(cbuf + (wave * 8 + k) * CW + 4 * lane);
#pragma unroll
        for (int k = 0; k < 8; ++k) { const int tok = wave * 8 + k; const f32x4 v = v8[k];
            const float mean = wave_sum((v[0] + v[1]) + (v[2] + v[3])) * (1.0f / 256.0f); const f32x4 d = v - mean;
            const float var = wave_sum((d[0] * d[0] + d[1] * d[1]) + (d[2] * d[2] + d[3] * d[3])) * (1.0f / 256.0f); const float r = __builtin_amdgcn_rsqf(var + EPS);
            const f32x4 y = d * r * lg + lb; v2u o; o.x = pk2(y[0] * sigmoidf_(y[0]), y[1] * sigmoidf_(y[1])); o.y = pk2(y[2] * sigmoidf_(y[2]), y[3] * sigmoidf_(y[3]));
            *(v2u*)(MIX + (((size_t)((tile * 64 + tok) >> 7) * 16 + (12 + (lane >> 4))) * 8192 + ((tile * 64 + tok) & 127) * 64 + ((4 * lane) & 63))) = o; }
        __syncthreads();
    }
}

namespace ret2 {
constexpr int RET_CPG = 4, RET_NG = 64 / RET_CPG, RET_WAVES = 4;
using sba::bf16x8; using sba::s16x4; using sba::f32x16; using sba::frag8; using sba::vtr; using sba::cvtpk;
__device__ __forceinline__ bf16x8 tr2(const LAS unsigned char* p) { const s16x4 a = vtr(p), b = vtr(p + 512); return (bf16x8){a[0], a[1], a[2], a[3], b[0], b[1], b[2], b[3]}; }
#define RET_MFMA(a, b, c) __builtin_amdgcn_mfma_f32_32x32x16_bf16(a, b, c, 0, 0, 0)
__device__ __forceinline__ v4u swap32x2(v4u v) { const auto r0 = __builtin_amdgcn_permlane32_swap(v.x, v.z, false, false); const auto r1 = __builtin_amdgcn_permlane32_swap(v.y, v.w, false, false); return (v4u){r0[0], r1[0], r0[1], r1[1]}; }
__device__ __forceinline__ void stage_tiles(const bf16* Kt, const bf16* Vt, LAS unsigned char* Kimg, LAS unsigned char* Vimg, int lane) {
    v4u kx[8], vx[8];
#pragma unroll
    for (int i = 0; i < 8; ++i) { kx[i] = ((const v4u*)Kt)[lane + 64 * i]; vx[i] = ((const v4u*)Vt)[lane + 64 * i]; }
    asm volatile("" ::: "memory");
#pragma unroll
    for (int i = 0; i < 8; ++i) { const int p = lane + 64 * i, key = p >> 3, c = p & 7; const unsigned dst = (unsigned)((c >> 2) * 4096 + key * 64 + (c & 3) * 16);
        *(LAS v4u*)(Kimg + dst) = kx[i]; *(LAS v4u*)(Vimg + dst) = vx[i]; }
    asm volatile("s_waitcnt lgkmcnt(0)" ::: "memory");
}
#define RET_KV() do { _Pragma("unroll") for (int ks = 0; ks < 4; ++ks) { \
            const bf16x8 k0_ = tr2(Kimg + ks * 1024 + vlane), k1_ = tr2(Kimg + 4096 + ks * 1024 + vlane), v0_ = tr2(Vimg + ks * 1024 + vlane), v1_ = tr2(Vimg + 4096 + ks * 1024 + vlane); \
            S00 = RET_MFMA(k0_, v0_, S00); S01 = RET_MFMA(k0_, v1_, S01); S10 = RET_MFMA(k1_, v0_, S10); S11 = RET_MFMA(k1_, v1_, S11); } \
        _Pragma("unroll") for (int r = 0; r < 16; ++r) { S00[r] *= g64; S01[r] *= g64; S10[r] *= g64; S11[r] *= g64; } } while (0)
__device__ __forceinline__ void ret_m1(int bh, int g, const Args& A, unsigned char* ws, LAS unsigned char* wlds, int lane) {
    const int hi = lane >> 5, hh = bh & 7; const float lg2 = A.ret_lg2[hh], g64 = __builtin_amdgcn_exp2f(64.f * lg2);
    const size_t hb = (size_t)bh * SEQ * HD; const bf16 *Rk = (const bf16*)(ws + WS_RK) + hb, *Rv = (const bf16*)(ws + WS_RV) + hb;
    LAS unsigned char* Kimg = wlds; LAS unsigned char* Vimg = wlds + 8192;
    const unsigned vlane = (unsigned)(((lane >> 4) & 1) * 32 + (lane & 3) * 8 + (4 * hi + ((lane & 15) >> 2)) * 64);
    f32x16 S00, S01, S10, S11;
#pragma unroll
    for (int r = 0; r < 16; ++r) { S00[r] = 0.f; S01[r] = 0.f; S10[r] = 0.f; S11[r] = 0.f; }
    v4u kx[2][8], vx[2][8];
#define RET_M1_LOAD(buf_, n_) do { const v4u* kt_ = (const v4u*)(Rk + (size_t)(n_) * 64 * HD); const v4u* vt_ = (const v4u*)(Rv + (size_t)(n_) * 64 * HD); \
        _Pragma("unroll") for (int i = 0; i < 8; ++i) { kx[buf_][i] = kt_[lane + 64 * i]; vx[buf_][i] = vt_[lane + 64 * i]; } } while (0)
    RET_M1_LOAD(0, RET_CPG * g);
#pragma unroll
    for (int s = 0; s < RET_CPG; ++s) {
        if (s + 1 < RET_CPG) RET_M1_LOAD((s + 1) & 1, RET_CPG * g + s + 1);
        asm volatile("" ::: "memory");
#pragma unroll
        for (int i = 0; i < 8; ++i) { const int p = lane + 64 * i, key = p >> 3, c = p & 7; const unsigned dst = (unsigned)((c >> 2) * 4096 + key * 64 + (c & 3) * 16);
            *(LAS v4u*)(Kimg + dst) = kx[s & 1][i]; *(LAS v4u*)(Vimg + dst) = vx[s & 1][i]; }
        asm volatile("s_waitcnt lgkmcnt(0)" ::: "memory");
        RET_KV(); }
#undef RET_M1_LOAD
    asm volatile("s_waitcnt lgkmcnt(0)" ::: "memory");
    LAS float* Tl = (LAS float*)wlds + lane;
#pragma unroll
    for (int r = 0; r < 16; ++r) { Tl[(0 * 16 + r) * 64] = S00[r]; Tl[(1 * 16 + r) * 64] = S01[r]; Tl[(2 * 16 + r) * 64] = S10[r]; Tl[(3 * 16 + r) * 64] = S11[r]; }
}
__device__ __forceinline__ void ret_m3(int bh, int g, int part, const Args& A, int l, unsigned char* ws, LAS unsigned char* wlds, int lane) {
    const int r32 = lane & 31, hi = lane >> 5, b = bh >> 3, hh = bh & 7; const float lg2 = A.ret_lg2[hh], g64 = __builtin_amdgcn_exp2f(64.f * lg2), g512 = __builtin_amdgcn_exp2f((float)(64 * RET_CPG) * lg2);
    const size_t hb = (size_t)bh * SEQ * HD;
    const bf16 *Rq = (const bf16*)(ws + WS_RQ) + hb, *Rk = (const bf16*)(ws + WS_RK) + hb, *Rv = (const bf16*)(ws + WS_RV) + hb, *Rg = (const bf16*)(ws + WS_RG); bf16* MIX = (bf16*)(ws + WS_MIX);
    LAS unsigned char* Kimg = wlds; LAS unsigned char* Vimg = wlds + 8192;
    const unsigned vlane = (unsigned)(((lane >> 4) & 1) * 32 + (lane & 3) * 8 + (4 * hi + ((lane & 15) >> 2)) * 64);
    f32x16 S00, S01, S10, S11;
#pragma unroll
    for (int r = 0; r < 16; ++r) { S00[r] = 0.f; S01[r] = 0.f; S10[r] = 0.f; S11[r] = 0.f; }
    {
        const int q = g >> 2, j = g & 3, nsteps = q + (j > 0 ? 1 : 0); const float g1024 = __builtin_amdgcn_exp2f(1024.f * lg2), gj = __builtin_amdgcn_exp2f((float)(64 * RET_CPG * j) * lg2);
        const float* Qb = (const float*)(ws + WS_RQT) + (size_t)(bh * 4) * 4096 + 4 * lane; const float* Pb = (const float*)(ws + WS_RP) + (size_t)((bh * 4 + q) * 3 + (j > 0 ? j - 1 : 0)) * 4096 + 4 * lane;
#define RET_LD16(dst_, p_, blk_) do { _Pragma("unroll") for (int j4 = 0; j4 < 4; ++j4) { const f32x4 v_ = *(const f32x4*)((p_) + ((blk_) * 4 + j4) * 256); dst_[4 * j4] = v_[0]; dst_[4 * j4 + 1] = v_[1]; dst_[4 * j4 + 2] = v_[2]; dst_[4 * j4 + 3] = v_[3]; } } while (0)
        if (nsteps > 0) {
            const float* p0 = q > 0 ? Qb : Pb; f32x16 t0, t1, t2, t3;
#pragma unroll
            for (int r0 = 0; r0 < 1; ++r0) { RET_LD16(t0, p0, 0); RET_LD16(t1, p0, 1); RET_LD16(t2, p0, 2); RET_LD16(t3, p0, 3); }
            for (int k = 0; k < nsteps; ++k) { f32x16 n0 = t0, n1 = t1, n2 = t2, n3 = t3; const float fac = k < q ? g1024 : gj;
                if (k + 1 < nsteps) { const float* pn = (k + 1 < q) ? Qb + (size_t)(k + 1) * 4096 : Pb;
#pragma unroll
                    for (int r0 = 0; r0 < 1; ++r0) { RET_LD16(n0, pn, 0); RET_LD16(n1, pn, 1); RET_LD16(n2, pn, 2); RET_LD16(n3, pn, 3); } }
#pragma unroll
                for (int r = 0; r < 16; ++r) { S00[r] = S00[r] * fac + t0[r]; S01[r] = S01[r] * fac + t1[r]; S10[r] = S10[r] * fac + t2[r]; S11[r] = S11[r] * fac + t3[r]; }
                t0 = n0; t1 = n1; t2 = n2; t3 = n3; } } }
    if (part == 1) { for (int s = 0; s < RET_CPG / 2; ++s) { const int n = RET_CPG * g + s;
            stage_tiles(Rk + (size_t)n * 64 * HD, Rv + (size_t)n * 64 * HD, Kimg, Vimg, lane); RET_KV(); } }
    for (int s = (part == 1) ? RET_CPG / 2 : 0; s < ((part == 0) ? RET_CPG / 2 : RET_CPG); ++s) {
        const int n = RET_CPG * g + s, t0 = 64 * n;
        stage_tiles(Rk + (size_t)n * 64 * HD, Rv + (size_t)n * 64 * HD, Kimg, Vimg, lane);
#pragma unroll
        for (int ih = 0; ih < 2; ++ih) {
            const bf16* qrow = Rq + (size_t)(t0 + 32 * ih + r32) * HD; const size_t orow = (size_t)b * SEQ + t0 + 32 * ih + r32;
            v4u gate16[2][2];
#pragma unroll
            for (int eh = 0; eh < 2; ++eh)
#pragma unroll
                for (int pq = 0; pq < 2; ++pq) gate16[eh][pq] = *(const v4u*)(Rg + hb + (size_t)(t0 + 32 * ih + r32) * HD + 32 * eh + 16 * pq + 8 * hi);
            bf16x8 qf[4];
#pragma unroll
            for (int d0 = 0; d0 < 4; ++d0) qf[d0] = *(const bf16x8*)(qrow + 16 * d0 + 8 * hi);
            f32x16 p, z0, z1;
#pragma unroll
            for (int r = 0; r < 16; ++r) { p[r] = 0.f; z0[r] = 0.f; z1[r] = 0.f; }
#pragma unroll
            for (int d0 = 0; d0 < 4; ++d0) { const bf16x8 kf = *(const LAS bf16x8*)(Kimg + (d0 >> 1) * 4096 + r32 * 64 + (d0 & 1) * 32 + hi * 16); p = RET_MFMA(kf, qf[d0], p); }
            if (ih == 0) {
#pragma unroll
                for (int r = 0; r < 16; ++r) { const int j = (r & 3) + 8 * (r >> 2) + 4 * hi; if (j > r32) p[r] = 0.f; }
            }
#pragma unroll
            for (int ks = 0; ks < 2; ++ks) { const bf16x8 pf = frag8(p, ks), v0 = tr2(Vimg + ks * 1024 + vlane), v1 = tr2(Vimg + 4096 + ks * 1024 + vlane); z0 = RET_MFMA(v0, pf, z0); z1 = RET_MFMA(v1, pf, z1); }
            if (ih == 1) {
#pragma unroll
                for (int r = 0; r < 16; ++r) p[r] = 0.f;
#pragma unroll
                for (int d0 = 0; d0 < 4; ++d0) { const bf16x8 kf = *(const LAS bf16x8*)(Kimg + (d0 >> 1) * 4096 + (32 + r32) * 64 + (d0 & 1) * 32 + hi * 16); p = RET_MFMA(kf, qf[d0], p); }
#pragma unroll
                for (int r = 0; r < 16; ++r) { const int j = (r & 3) + 8 * (r >> 2) + 4 * hi; if (j > r32) p[r] = 0.f; }
#pragma unroll
                for (int ks = 0; ks < 2; ++ks) { const bf16x8 pf = frag8(p, ks), v0 = tr2(Vimg + (2 + ks) * 1024 + vlane), v1 = tr2(Vimg + 4096 + (2 + ks) * 1024 + vlane); z0 = RET_MFMA(v0, pf, z0); z1 = RET_MFMA(v1, pf, z1); }
            }
#pragma unroll
            for (int ks = 0; ks < 4; ++ks) { const v4u qx = swap32x2(__builtin_bit_cast(v4u, qf[ks]));
                const bf16x8 qa = __builtin_bit_cast(bf16x8, (v4u){qx.x, qx.y, qx.z, qx.w});
                const bf16x8 s0 = (ks < 2) ? frag8(S00, ks & 1) : frag8(S10, ks & 1), s1 = (ks < 2) ? frag8(S01, ks & 1) : frag8(S11, ks & 1);
                z0 = RET_MFMA(s0, qa, z0); z1 = RET_MFMA(s1, qa, z1); }
            const float gi = __builtin_amdgcn_exp2f((float)(32 * ih + r32) * lg2); float ss = 0.f;
#pragma unroll
            for (int r = 0; r < 16; ++r) ss += z0[r] * z0[r] + z1[r] * z1[r];
            ss = xor32_sum(ss) * (gi * gi);
            const float rn = __builtin_amdgcn_rsqf(ss * (1.0f / 64.0f) + EPS) * gi;
            bf16* dst = MIX + (((size_t)(((int)orow) >> 7) * 16 + (4 + hh)) * 8192 + (((int)orow) & 127) * 64 + (8 * hi));
#pragma unroll
            for (int eh = 0; eh < 2; ++eh)
#pragma unroll
                for (int pq = 0; pq < 2; ++pq) { const v4u g4 = swap32x2(gate16[eh][pq]);
                    v4u o;
#pragma unroll
                    for (int qq = 0; qq < 2; ++qq) { const int q = 2 * pq + qq; const unsigned gx = qq ? g4.z : g4.x, gy = qq ? g4.w : g4.y;
                        const float y0 = (eh ? z1 : z0)[4 * q + 0] * rn * bflo(gx), y1 = (eh ? z1 : z0)[4 * q + 1] * rn * bfhi(gx);
                        const float y2 = (eh ? z1 : z0)[4 * q + 2] * rn * bflo(gy), y3 = (eh ? z1 : z0)[4 * q + 3] * rn * bfhi(gy);
                        if (qq) { o.z = cvtpk(y0, y1); o.w = cvtpk(y2, y3); } else { o.x = cvtpk(y0, y1); o.y = cvtpk(y2, y3); } }
                    *(v4u*)(dst + 32 * eh + 16 * pq) = swap32x2(o); }
        }
        RET_KV();
    }
}
#undef RET_KV
#undef RET_MFMA
__device__ __forceinline__ void ret_pass(Frame& F, const Args& A, int l, bool m3) {
#ifndef RET_M3_SPLIT
#define RET_M3_SPLIT 1
#endif
    if (m3 && RET_M3_SPLIT) {
        for (int it = blockIdx.x * NWAVES + F.wave; it < BATCH * RH * RET_NG * 2; it += gridDim.x * NWAVES)
            { const int part = (it & 1) ^ ((F.wave >> 2) & 1);
              if (part) __builtin_amdgcn_s_setprio(1);
              ret_m3((it >> 1) / RET_NG, (it >> 1) % RET_NG, part, A, l, F.ws, F.lds + RING_OFF + F.wave * 16384, F.lane);
              __builtin_amdgcn_s_setprio(0); }
        return; }
    if (m3) { if (F.wave >= RET_WAVES) return;
        for (int it = blockIdx.x * RET_WAVES + F.wave; it < BATCH * RH * RET_NG; it += gridDim.x * RET_WAVES) ret_m3(it / RET_NG, it % RET_NG, 2, A, l, F.ws, F.lds + RING_OFF + F.wave * 16384, F.lane);
        return; }
    if (F.wave >= RET_WAVES) return;
    for (int it = blockIdx.x * RET_WAVES + F.wave; it < BATCH * RH * RET_NG; it += gridDim.x * RET_WAVES)
        ret_m1(it / RET_NG, it % RET_NG, A, F.ws, F.lds + RING_OFF + F.wave * 16384, F.lane);
}
__device__ __forceinline__ void quarter_combine(Frame& F, const Args& A) {
    if (F.wave >= RET_WAVES) return;
    for (int c = blockIdx.x; c < BATCH * RH * 4; c += gridDim.x) { const int bh = c >> 2; const float g256 = __builtin_amdgcn_exp2f((float)(64 * RET_CPG) * A.ret_lg2[bh & 7]);
        const LAS float* T = (const LAS float*)(F.lds + RING_OFF) + (F.wave * 16) * 64 + F.lane;     float* Q = (float*)(F.ws + WS_RQT) + (size_t)c * 4096 + (F.wave * 16) * 64 + F.lane;
        const __amdgpu_buffer_rsrc_t qrs = __builtin_amdgcn_make_buffer_rsrc((void*)(F.ws + WS_RQT), 0, 4u * 1024u * 1024u, 0x00020000);
        float tv[4][16];
#pragma unroll
        for (int i = 0; i < 4; ++i)
#pragma unroll
            for (int r = 0; r < 16; ++r) tv[i][r] = T[i * 4096 + r * 64];
        float acc[16];
#pragma unroll
        for (int r = 0; r < 16; ++r) acc[r] = tv[0][r];
        float* Pv = (float*)(F.ws + WS_RP) + (size_t)(c * 3) * 4096;
        float* P = nullptr; (void)P;
#pragma unroll
        for (int i = 1; i < 4; ++i) {
#pragma unroll
            for (int j = 0; j < 4; ++j) *(f32x4*)(Pv + (size_t)(i - 1) * 4096 + (size_t)((F.wave * 4 + j) * 64 + F.lane) * 4) = (f32x4){acc[4 * j], acc[4 * j + 1], acc[4 * j + 2], acc[4 * j + 3]};
#pragma unroll
            for (int r = 0; r < 16; ++r) acc[r] = acc[r] * g256 + tv[i][r]; }
#pragma unroll
        for (int j = 0; j < 4; ++j) { const f32x4 qv = {acc[4 * j], acc[4 * j + 1], acc[4 * j + 2], acc[4 * j + 3]};
            __builtin_amdgcn_raw_buffer_store_b128(__builtin_bit_cast(v4u, qv), qrs, (unsigned)(c * 16384 + ((F.wave * 4 + j) * 64 + F.lane) * 16), 0,   16); }
    }
    asm volatile("s_waitcnt vmcnt(0)" ::: "memory");
}
__device__ __forceinline__ void quarter_publish(unsigned* flags, int tid) {
    __syncthreads();
    if (tid == 0) __hip_atomic_store(flags + blockIdx.x, 1u, __ATOMIC_RELAXED, __HIP_MEMORY_SCOPE_AGENT);
}
__device__ __forceinline__ void quarter_wait(unsigned* flags, int tid) {
    const int c = (int)blockIdx.x, q = c & 3;
    if (tid == 0 && q > 0) {
        for (int k = 0; k < q; ++k) { unsigned sp_ = 0u;
            while (__hip_atomic_load(flags + (c & ~3) + k, __ATOMIC_RELAXED, __HIP_MEMORY_SCOPE_AGENT) == 0u) { __builtin_amdgcn_s_sleep(2); if (++sp_ > XB_SPIN_CAP) break; } }
        __builtin_amdgcn_fence(__ATOMIC_ACQUIRE, "agent");
        asm volatile("s_waitcnt vmcnt(0)" ::: "memory");
    }
    __syncthreads();
}
}

constexpr int PH_PER_LAYER = 5, N_PHASES = 1 + DEPTH * PH_PER_LAYER;
constexpr int CW_QFLAG = 1024;
__global__ void __launch_bounds__(NWAVES * 64, 2) mk_fwd(Args args) {
    extern __shared__ __attribute__((aligned(16))) unsigned char lds[];
    Frame F;
    F.lds = (LAS unsigned char*)lds; F.tid = threadIdx.x; F.lane = F.tid & 63; F.wave = __builtin_amdgcn_readfirstlane(F.tid >> 6); F.gw = blockIdx.x * NWAVES + F.wave; F.ws = args.ws;
#if MK_ONE_LAUNCH
    cg::grid_group grid = cg::this_grid();
    for (int u = threadIdx.x; u < (LDS_BYTES - LDSCTL_OFF) / 4; u += NWAVES * 64) ((LAS unsigned*)(F.lds + LDSCTL_OFF))[u] = 0u;
    __syncthreads();
    XcdBarrier bar = xcd_barrier_post((unsigned*)(args.ws + WS_CTL) + CW_BAR, (volatile LAS unsigned*)(F.lds + MISC_OFF) + 8);
#endif
    for (int ph = args.ph_lo; ph < args.ph_hi; ++ph) {
        { int t_ = threadIdx.x; asm volatile("" : "+v"(t_)); F.tid = t_; F.lane = t_ & 63; F.wave = __builtin_amdgcn_readfirstlane(t_ >> 6); F.gw = blockIdx.x * NWAVES + F.wave; }
#ifdef PROBE_KIND
#ifndef PROBE_REPS
#define PROBE_REPS 1
#endif
        const int pp = ph > PROBE_KIND + PROBE_REPS ? ph - PROBE_REPS : (ph > PROBE_KIND ? PROBE_KIND : ph);
#else
        const int pp = ph;
#endif
        const int l = pp == 0 ? 0 : (pp - 1) / PH_PER_LAYER, kind = pp == 0 ? 0 : ((pp - 1) % PH_PER_LAYER) + 1;
        unsigned char* wl = F.ws + WS_W + (size_t)l * W_LAYER;
        if (kind == 0) p0_prologue(F, args);
        else if (kind == 1) {
            pg8::Gemm g{(const pg8::bf16_t*)(F.ws + WS_XNG), (const pg8::bf16_t*)(wl + W_IN), M, INC, DM, 1}; pg8::StaticOrder S; S.init(M, INC, gridDim.x, (int)blockIdx.x);
            pg8::fill_rs(F.lds, S, (const float*)(F.ws + WS_SSQ));
            pg8::EpiInProj E{F.lds, F.ws, args.sbq_g + l * HD, args.sbk_g + l * HD, args.pw_b + l * 2 * CW, args.ret_g + l * RW, WS_QS, WS_KS, WS_VS, WS_RQ, WS_RK, WS_RV, WS_RG, WS_HC, 0, SB_C2, EPS};
            pg8::gemm_phase<pg8::EpiInProj, pg8::StaticOrder, PG8_ALIGN, PG8_SP2>(F.lds + RING_OFF, g, S, E);
            if (blockIdx.x >= 128) { const int c0 = l * CVT_I_L + CVT_I_IN, c1 = (l + 1 < DEPTH) ? c0 + CVT_I_L : DEPTH * CVT_I_L;
                convert_weights(F, args, c0, c1, ((int)blockIdx.x - 128) * NWAVES + F.wave, ((int)gridDim.x - 128) * NWAVES); }
        }
        else if (kind == 2) { unsigned* qf = (unsigned*)(F.ws + WS_CTL) + CW_QFLAG + l * 256;
            ret2::ret_pass(F, args, l, false); conv_phase(F, args, l); ret2::quarter_combine(F, args); ret2::quarter_publish(qf, F.tid); sba::sb_phase(F); ret2::quarter_wait(qf, F.tid); ret2::ret_pass(F, args, l, true); }
        else if (kind == 4) {
            pg8::Gemm g{(const pg8::bf16_t*)(F.ws + WS_XNG), (const pg8::bf16_t*)(wl + W_1), M, DFF, DM, 1}; pg8::StaticOrder S; S.init(M, DFF, gridDim.x, (int)blockIdx.x);
            pg8::fill_rs(F.lds, S, (const float*)(F.ws + WS_SSQ));
            pg8::EpiScaleBf16 E{(pg8::bf16_t*)(F.ws + WS_F), DFF, F.lds, 1};
            pg8::gemm_phase<pg8::EpiScaleBf16, pg8::StaticOrder, PG8_ALIGN, PG8_SP2>(F.lds + RING_OFF, g, S, E);
        }
        else {
            const bool ff = kind == 5; const bool last = ff && (l + 1 == DEPTH);
            pg8::Gemm g{(const pg8::bf16_t*)(F.ws + (ff ? WS_F : WS_MIX)), (const pg8::bf16_t*)(wl + (ff ? W_2 : W_OUT)), M, DM, ff ? DFF : DM, 1}; pg8::StaticOrder S; S.init(M, DM, gridDim.x, (int)blockIdx.x);
            pg8::EpiResid E{(pg8::bf16_t*)(F.ws + WS_XNG), last ? args.out : nullptr, (float*)(F.ws + WS_SSQ)};
            pg8::gemm_phase<pg8::EpiResid, pg8::StaticOrder, PG8_ALIGN, PG8_SP2>(F.lds + RING_OFF, g, S, E);
        }
#if MK_ONE_LAUNCH
        if (ph + 1 < args.ph_hi) { if (args.ph_hi > 4096) grid.sync(); xcd_barrier(bar); }
#endif
    }
}

extern "C" void kernel_launch(void* const* d_in, const int* in_sizes, int n_in, void* d_out, int out_size, void* d_ws, size_t ws_size, hipStream_t stream) {
    static int grid = 0;
    if (grid == 0) {
        if (n_in != 15 || in_sizes[0] != M * DM || out_size != M * DM || ws_size < WS_END) { fprintf(stderr, "kernel_launch: unexpected shapes (n_in %d, in0 %d, out %d, ws %zu); nothing launched\n", n_in, n_in > 0 ? in_sizes[0] : -1, out_size, ws_size); grid = -1; return; }
        int dev = 0, cus = 0, per_cu = 0;
        if (hipGetDevice(&dev) != hipSuccess || hipDeviceGetAttribute(&cus, hipDeviceAttributeMultiprocessorCount, dev) != hipSuccess) { grid = -1; return; }
        if (hipFuncSetAttribute((const void*)mk_fwd, hipFuncAttributeMaxDynamicSharedMemorySize, LDS_BYTES) != hipSuccess) { fprintf(stderr, "kernel_launch: hipFuncSetAttribute failed\n"); grid = -1; return; }
        if (hipOccupancyMaxActiveBlocksPerMultiprocessor(&per_cu, (const void*)mk_fwd, NWAVES * 64, LDS_BYTES) != hipSuccess || per_cu < 1) { fprintf(stderr, "kernel_launch: occupancy query says %d blocks per CU\n", per_cu); per_cu = 1; }
        (void)hipGetLastError();
        if (cus < 256) { fprintf(stderr, "kernel_launch: built for a 256-CU device (unit lists and LDS tables are sized for 256 workgroups); found %d CUs; nothing launched\n", cus); grid = -1; return; }
        grid = 256;
    }
    if (grid < 0) return;
    (void)hipMemsetAsync((char*)d_ws + WS_CTL, 0, CTL_ZERO_BYTES, stream);
    Args a{};
    a.x = (const float*)d_in[0]; a.mix_g = (const float*)d_in[1]; a.w_in = (const float*)d_in[2]; a.sbq_g = (const float*)d_in[3]; a.sbk_g = (const float*)d_in[4]; a.ret_g = (const float*)d_in[5];
    a.pw_b = (const float*)d_in[6]; a.dw_w = (const float*)d_in[7]; a.dw_b = (const float*)d_in[8]; a.ln_g = (const float*)d_in[9]; a.ln_b = (const float*)d_in[10]; a.w_out = (const float*)d_in[11];
    a.mlp_g = (const float*)d_in[12]; a.w_ff1 = (const float*)d_in[13]; a.w_ff2 = (const float*)d_in[14];
    a.out = (float*)d_out; a.ws = (unsigned char*)d_ws;
    for (int h = 0; h < 8; ++h) a.ret_lg2[h] = (float)log2(1.0 - exp2(-5.0 - (double)h));
#if MK_ONE_LAUNCH
#ifdef PROBE_KIND
    a.ph_lo = 0; a.ph_hi = N_PHASES + PROBE_REPS;
#else
    a.ph_lo = 0; a.ph_hi = N_PHASES;
#endif
    void* kargs[] = {&a};
    hipError_t e = hipLaunchCooperativeKernel((const void*)mk_fwd, dim3(grid), dim3(NWAVES * 64), kargs, LDS_BYTES, stream);
    if (e != hipSuccess) fprintf(stderr, "kernel_launch: cooperative launch failed: %s (grid %d)\n", hipGetErrorString(e), grid);
#else
    for (int p = 0; p < N_PHASES; ++p) { a.ph_lo = p; a.ph_hi = p + 1; hipLaunchKernelGGL(mk_fwd, dim3(grid), dim3(NWAVES * 64), LDS_BYTES, stream, a); }
#endif
}
```
